# Optimizing an MI355X kernel written in HIP

```python
import jax, jax.numpy as jnp
from jax import lax
import numpy as np

D_MODEL = 1024
BATCH = 1
SEQ = 16384
DEPTH = 1
DEC_BATCH = 4
DEC_SEQ = 8192
PAST_LEN = 128

HEAD_DIM = 64
N_Q_HEADS = 8
N_KV_HEADS = 2
ATTN_WIDTH = N_Q_HEADS * HEAD_DIM
KV_WIDTH = N_KV_HEADS * HEAD_DIM
WINDOW = 128
ATTN_BLOCK = 128
ROPE_THETA = 10000.0
HGRN_HEADS = 4
HGRN_DK = 128
HGRN_DV = 128
HGRN_WIDTH = HGRN_HEADS * HGRN_DK
HGRN_CHUNK = 64
D_FF = 2816
CONV_WIDTH = 3
NORM_EPS = 1e-6
D_IN = ATTN_WIDTH + 2 * KV_WIDTH + 5 * HGRN_WIDTH + 2 * D_MODEL

kernel_name = 'hybrid_bidir_swa_hgrn2_encoder'


def rms_norm(x, w):
    xf = x.astype(jnp.float32)
    y = xf * lax.rsqrt(jnp.mean(xf * xf, axis=-1, keepdims=True) + NORM_EPS)
    return (y * w.astype(jnp.float32)).astype(x.dtype)


def rotary(x):
    T = x.shape[1]
    half = HEAD_DIM // 2
    inv_freq = ROPE_THETA ** (-jnp.arange(half, dtype=jnp.float32) / half)
    ang = jnp.arange(T, dtype=jnp.float32)[:, None] * inv_freq[None, :]
    cos = jnp.cos(ang)[None, :, None, :]
    sin = jnp.sin(ang)[None, :, None, :]
    x1 = x[..., :half].astype(jnp.float32)
    x2 = x[..., half:].astype(jnp.float32)
    out = jnp.concatenate([x1 * cos - x2 * sin, x2 * cos + x1 * sin], axis=-1)
    return out.astype(x.dtype)


def window_attention(q, k, v, sink):
    B, T = q.shape[0], q.shape[1]
    C = ATTN_BLOCK
    nb = T // C
    R = N_Q_HEADS // N_KV_HEADS
    qb = q.reshape(B, nb, C, N_KV_HEADS, R, HEAD_DIM)

    def windows(t):
        tp = jnp.pad(t, ((0, 0), (C, C), (0, 0), (0, 0))).reshape(B, nb + 2, C, N_KV_HEADS, HEAD_DIM)
        return jnp.concatenate([tp[:, :-2], tp[:, 1:-1], tp[:, 2:]], axis=2)

    kw = windows(k)
    vw = windows(v)
    s = jnp.einsum('bnqgrd,bnkgd->bngrqk', qb, kw).astype(jnp.float32) * (HEAD_DIM ** -0.5)
    blk = jnp.arange(nb)[:, None, None]
    qpos = blk * C + jnp.arange(C)[None, :, None]
    kpos = (blk - 1) * C + jnp.arange(3 * C)[None, None, :]
    valid = (jnp.abs(qpos - kpos) <= WINDOW) & (kpos >= 0) & (kpos < T)
    s = jnp.where(valid[None, :, None, None], s, -jnp.inf)
    sink_l = sink.astype(jnp.float32).reshape(N_KV_HEADS, R)[None, None, :, :, None, None]
    m = jnp.maximum(jnp.max(s, axis=-1, keepdims=True), sink_l)
    p = jnp.exp(s - m)
    denom = jnp.sum(p, axis=-1, keepdims=True) + jnp.exp(sink_l - m)
    o = jnp.einsum('bngrqk,bnkgd->bnqgrd', (p / denom).astype(v.dtype), vw)
    return o.reshape(B, T, ATTN_WIDTH)


def gla_chunk_scan(q, k, v, g):
    B, T, H, DK = q.shape
    DV = v.shape[-1]
    C = HGRN_CHUNK
    n = T // C
    rs = lambda t: t.reshape(B, n, C, H, t.shape[-1])
    q, k, v, g = rs(q), rs(k), rs(v), rs(g)
    b = jnp.cumsum(g, axis=2)
    ref = b[:, :, C // 2 - 1:C // 2]
    b_last = b[:, :, -1:]
    A = jnp.einsum('bnihd,bnjhd->bnhij', q * jnp.exp(b - ref), k * jnp.exp(ref - b))
    lower = jnp.tril(jnp.ones((C, C), dtype=bool))
    A = jnp.where(lower, A, 0.0)
    o_intra = jnp.einsum('bnhij,bnjhv->bnihv', A, v)
    q_dec = q * jnp.exp(b)
    k_dec = k * jnp.exp(b_last - b)
    decay = jnp.exp(b_last[:, :, 0])

    def step(S, xs):
        qd, kd, vv, dc = xs
        o = jnp.einsum('bihd,bhdv->bihv', qd, S)
        S = dc[..., None] * S + jnp.einsum('bihd,bihv->bhdv', kd, vv)
        return S, o

    S0 = jnp.zeros((B, H, DK, DV), jnp.float32)
    xs = (jnp.moveaxis(q_dec, 1, 0), jnp.moveaxis(k_dec, 1, 0), jnp.moveaxis(v, 1, 0), jnp.moveaxis(decay, 1, 0))
    _, o_inter = lax.scan(step, S0, xs)
    o = o_intra + jnp.moveaxis(o_inter, 0, 1)
    return o.reshape(B, T, H, DV)


def hgrn2_bidir(xq, xf_fwd, xf_bwd, xi, xg, lb, gnorm_w):
    B, T = xq.shape[0], xq.shape[1]
    sh = lambda t: t.astype(jnp.float32).reshape(B, T, HGRN_HEADS, HGRN_DK)
    q = sh(xq)
    i = xi.astype(jnp.float32).reshape(B, T, HGRN_HEADS, HGRN_DV)

    def gates(xf, lb_d):
        lbh = lb_d.reshape(HGRN_HEADS, HGRN_DK)
        f = lbh + (1.0 - lbh) * jax.nn.sigmoid(sh(xf))
        return jnp.log(f), 1.0 - f

    g_f, k_f = gates(xf_fwd, lb[0])
    g_b, k_b = gates(xf_bwd, lb[1])
    o_f = gla_chunk_scan(q, k_f, i, g_f)
    flip = lambda t: jnp.flip(t, axis=1)
    o_b = flip(gla_chunk_scan(flip(q), flip(k_b), flip(i), flip(g_b)))
    o = o_f + o_b
    o = o * lax.rsqrt(jnp.mean(o * o, axis=-1, keepdims=True) + NORM_EPS)
    o = o.reshape(B, T, HGRN_WIDTH) * gnorm_w.astype(jnp.float32) * jax.nn.silu(xg.astype(jnp.float32))
    return o.astype(xq.dtype)


def conv_ffn(x, w_up, conv_w, conv_b, w_down):
    u = x @ w_up
    up = jnp.pad(u, ((0, 0), (1, 1), (0, 0)))
    u = conv_w[0] * up[:, :-2] + conv_w[1] * up[:, 1:-1] + conv_w[2] * up[:, 2:] + conv_b
    val, gate = jnp.split(u, 2, axis=-1)
    return (jax.nn.silu(gate) * val) @ w_down


def encoder_layer(x, lb, norm_mix_w, w_in, attn_sink, hgrn_norm_w, w_attn_out, w_hgrn_out,
                  w_mix_out, norm_ffn_w, w_up, conv_w, conv_b, w_down):
    B, T = x.shape[0], x.shape[1]
    h = rms_norm(x, norm_mix_w)
    z = h @ w_in
    sizes = [ATTN_WIDTH, KV_WIDTH, KV_WIDTH] + [HGRN_WIDTH] * 5 + [D_MODEL, D_MODEL]
    offs = [int(o) for o in np.cumsum(sizes)[:-1]]
    aq, ak, av, hq, hf_f, hf_b, hi, hg, gate_a, gate_h = jnp.split(z, offs, axis=-1)
    q = rotary(aq.reshape(B, T, N_Q_HEADS, HEAD_DIM))
    k = rotary(ak.reshape(B, T, N_KV_HEADS, HEAD_DIM))
    v = av.reshape(B, T, N_KV_HEADS, HEAD_DIM)
    a = window_attention(q, k, v, attn_sink)
    r = hgrn2_bidir(hq, hf_f, hf_b, hi, hg, lb, hgrn_norm_w)
    mixed = jax.nn.sigmoid(gate_a) * (a @ w_attn_out) + jax.nn.sigmoid(gate_h) * (r @ w_hgrn_out)
    x = x + mixed @ w_mix_out
    x = x + conv_ffn(rms_norm(x, norm_ffn_w), w_up, conv_w, conv_b, w_down)
    return x


def trunk(x, norm_mix_w, w_in, attn_sink, hgrn_lb_logits, hgrn_norm_w, w_attn_out, w_hgrn_out,
          w_mix_out, norm_ffn_w, w_up, conv_w, conv_b, w_down, norm_final_w):
    lb_all = jnp.cumsum(jax.nn.softmax(hgrn_lb_logits.astype(jnp.float32), axis=0), axis=0)
    for l in range(DEPTH):
        x = encoder_layer(x, lb_all[l], norm_mix_w[l], w_in[l], attn_sink[l], hgrn_norm_w[l],
                          w_attn_out[l], w_hgrn_out[l], w_mix_out[l], norm_ffn_w[l],
                          w_up[l], conv_w[l], conv_b[l], w_down[l])
    return rms_norm(x, norm_final_w)


def setup_inputs(seed: int = 0) -> dict:
    key = jax.random.key(seed)
    ks = jax.random.split(key, 16)
    nrm = lambda k, shape, s: jax.random.normal(k, shape, jnp.float32) * s
    return {
        'x_prompt': nrm(ks[0], (BATCH, SEQ, D_MODEL), 1.0),
        'x_sample': nrm(ks[1], (DEC_BATCH, DEC_SEQ, D_MODEL), 1.0),
        'norm_mix_w': 1.0 + nrm(ks[2], (DEPTH, D_MODEL), 0.02),
        'w_in': nrm(ks[3], (DEPTH, D_MODEL, D_IN), D_MODEL ** -0.5),
        'attn_sink': nrm(ks[4], (DEPTH, N_Q_HEADS), 0.5),
        'hgrn_lb_logits': nrm(ks[5], (DEPTH + 1, 2, HGRN_WIDTH), 0.5),
        'hgrn_norm_w': 1.0 + nrm(ks[6], (DEPTH, HGRN_WIDTH), 0.02),
        'w_attn_out': nrm(ks[7], (DEPTH, ATTN_WIDTH, D_MODEL), ATTN_WIDTH ** -0.5),
        'w_hgrn_out': nrm(ks[8], (DEPTH, HGRN_WIDTH, D_MODEL), HGRN_WIDTH ** -0.5),
        'w_mix_out': nrm(ks[9], (DEPTH, D_MODEL, D_MODEL), D_MODEL ** -0.5),
        'norm_ffn_w': 1.0 + nrm(ks[10], (DEPTH, D_MODEL), 0.02),
        'w_up': nrm(ks[11], (DEPTH, D_MODEL, 2 * D_FF), D_MODEL ** -0.5),
        'conv_w': nrm(ks[12], (DEPTH, CONV_WIDTH, 2 * D_FF), CONV_WIDTH ** -0.5),
        'conv_b': nrm(ks[13], (DEPTH, 2 * D_FF), 0.01),
        'w_down': nrm(ks[14], (DEPTH, D_FF, D_MODEL), D_FF ** -0.5),
        'norm_final_w': 1.0 + nrm(ks[15], (D_MODEL,), 0.02),
    }


def reference(x_prompt, x_sample, norm_mix_w, w_in, attn_sink, hgrn_lb_logits, hgrn_norm_w,
              w_attn_out, w_hgrn_out, w_mix_out, norm_ffn_w, w_up, conv_w, conv_b, w_down,
              norm_final_w):
    y_prompt = trunk(x_prompt, norm_mix_w, w_in, attn_sink, hgrn_lb_logits, hgrn_norm_w, w_attn_out,
                     w_hgrn_out, w_mix_out, norm_ffn_w, w_up, conv_w, conv_b, w_down, norm_final_w)
    y_sample = trunk(x_sample, norm_mix_w, w_in, attn_sink, hgrn_lb_logits, hgrn_norm_w, w_attn_out,
                     w_hgrn_out, w_mix_out, norm_ffn_w, w_up, conv_w, conv_b, w_down, norm_final_w)
    return (y_prompt, y_sample)
```

```cpp
#include <hip/hip_runtime.h>
#include <hip/hip_cooperative_groups.h>
#include <cstdio>
namespace cg = cooperative_groups;

#ifndef MEGA
#define MEGA 1
#endif

#define LAS __attribute__((address_space(3)))
typedef unsigned short bf16_t;
typedef short bf16x8 __attribute__((ext_vector_type(8)));
typedef short s16x4 __attribute__((ext_vector_type(4)));
typedef float f32x4 __attribute__((ext_vector_type(4)));
typedef unsigned u32x4 __attribute__((ext_vector_type(4)));
typedef unsigned u32x2 __attribute__((ext_vector_type(2)));

constexpr int T_TOK = 49152, DM = 1024, DIN = 5376, DFF = 2816;
constexpr int NCHUNK = 768;
constexpr int PADROWS = 16512 + 4 * 8384;
constexpr float EPS = 1e-6f;

constexpr size_t OFF_WIN = 0;
constexpr size_t OFF_WCAT = OFF_WIN + (size_t)DIN * 1024 * 2;
constexpr size_t OFF_WMIX = OFF_WCAT + (size_t)1024 * 1024 * 2;
constexpr size_t OFF_WUP = OFF_WMIX + (size_t)1024 * 1024 * 2;
constexpr size_t OFF_WDN = OFF_WUP + (size_t)5632 * 1024 * 2;
constexpr size_t OFF_ROTC = OFF_WDN + (size_t)1024 * DFF * 2;
constexpr size_t OFF_ROTS = OFF_ROTC + (size_t)16384 * 32 * 4;
constexpr size_t OFF_SS1 = OFF_ROTS + (size_t)16384 * 32 * 4;
constexpr size_t OFF_SS2 = OFF_SS1 + (size_t)T_TOK * 4;
constexpr size_t OFF_DC = OFF_SS2 + (size_t)T_TOK * 4;
constexpr size_t OFF_H = OFF_DC + (size_t)NCHUNK * 4 * 2 * 128 * 4;
constexpr size_t OFF_QH = OFF_H + (size_t)PADROWS * 1024 * 2;
constexpr size_t OFF_K = OFF_QH + (size_t)T_TOK * 1024 * 2;
constexpr size_t OFF_V = OFF_K + (size_t)T_TOK * 128 * 2;
constexpr size_t OFF_GF = OFF_V + (size_t)T_TOK * 128 * 2;
constexpr size_t OFF_GB = OFF_GF + (size_t)T_TOK * 512 * 2;
constexpr size_t OFF_HI = OFF_GB + (size_t)T_TOK * 512 * 2;
constexpr size_t OFF_HG = OFF_HI + (size_t)T_TOK * 512 * 2;
constexpr size_t WS_END = OFF_HG + (size_t)T_TOK * 512 * 2;
constexpr size_t OFF_ACT = OFF_QH;
constexpr size_t OFF_MIXED = OFF_GF;

constexpr int XST_OFF = 140288;
constexpr int LDS_BYTES = XST_OFF + 16;
constexpr size_t OFF_EREF_REL = (size_t)60 << 20;
constexpr size_t OFF_BAR = WS_END;

struct Params {
    const float* x_prompt; const float* x_sample; const float* norm_mix_w; const float* w_in; const float* attn_sink;
    const float* lb_logits; const float* hgrn_norm_w; const float* w_attn_out; const float* w_hgrn_out; const float* w_mix_out;
    const float* norm_ffn_w; const float* w_up; const float* conv_w; const float* conv_b; const float* w_down; const float* norm_final_w;
    float* out; unsigned char* ws;
    int ph_lo, ph_hi, coop, pad0;
};

typedef __bf16 bf2_t __attribute__((ext_vector_type(2)));
typedef float f32x2_t __attribute__((ext_vector_type(2)));
__device__ __forceinline__ unsigned pk_bf16(float lo, float hi) { f32x2_t v = {lo, hi}; bf2_t r = __builtin_convertvector(v, bf2_t); return __builtin_bit_cast(unsigned, r); }
__device__ __forceinline__ float bf2f(unsigned short b) { return __uint_as_float(((unsigned)b) << 16); }
__device__ __forceinline__ float bflo(unsigned u) { return __uint_as_float(u << 16); }
__device__ __forceinline__ float bfhi(unsigned u) { return __uint_as_float(u & 0xffff0000u); }
__device__ __forceinline__ void store8(bf16_t* dst, f32x4 a, f32x4 b) {
    u32x4 v; v[0] = pk_bf16(a[0], a[1]); v[1] = pk_bf16(a[2], a[3]); v[2] = pk_bf16(b[0], b[1]); v[3] = pk_bf16(b[2], b[3]);
    *(u32x4*)dst = v;
}
__device__ __forceinline__ void load8(const bf16_t* src, f32x4& a, f32x4& b) {
    u32x4 v = *(const u32x4*)src;
    a[0] = bflo(v[0]); a[1] = bfhi(v[0]); a[2] = bflo(v[1]); a[3] = bfhi(v[1]);
    b[0] = bflo(v[2]); b[1] = bfhi(v[2]); b[2] = bflo(v[3]); b[3] = bfhi(v[3]);
}
__device__ __forceinline__ f32x4 load4bf(const bf16_t* src) { u32x2 v = *(const u32x2*)src; f32x4 a; a[0] = bflo(v[0]); a[1] = bfhi(v[0]); a[2] = bflo(v[1]); a[3] = bfhi(v[1]); return a; }
__device__ __forceinline__ f32x4 load4bf_lds(const LAS unsigned char* src) { u32x2 v = *(const LAS u32x2*)src; f32x4 a; a[0] = bflo(v[0]); a[1] = bfhi(v[0]); a[2] = bflo(v[1]); a[3] = bfhi(v[1]); return a; }
__device__ __forceinline__ u32x2 pack4(f32x4 a) { u32x2 v; v[0] = pk_bf16(a[0], a[1]); v[1] = pk_bf16(a[2], a[3]); return v; }
__device__ __forceinline__ float sigmoidf_(float z) { return __builtin_amdgcn_rcpf(1.0f + __builtin_amdgcn_exp2f(z * -1.4426950408889634f)); }
__device__ __forceinline__ f32x4 mfma16(bf16x8 a, bf16x8 b, f32x4 c) { return __builtin_amdgcn_mfma_f32_16x16x32_bf16(a, b, c, 0, 0, 0); }
__device__ __forceinline__ bf16x8 tr_frag(const LAS unsigned char* tile, int stride, int rowA, int rowB, int c0, int fr) {
    const LAS unsigned char* pa = tile + (rowA + (fr >> 2)) * stride + (c0 + 4 * (fr & 3)) * 2;
    const LAS unsigned char* pb = tile + (rowB + (fr >> 2)) * stride + (c0 + 4 * (fr & 3)) * 2;
    s16x4 lo = __builtin_amdgcn_ds_read_tr16_b64_v4i16((LAS s16x4*)pa);
    s16x4 hi = __builtin_amdgcn_ds_read_tr16_b64_v4i16((LAS s16x4*)pb);
    bf16x8 r; r[0] = lo[0]; r[1] = lo[1]; r[2] = lo[2]; r[3] = lo[3]; r[4] = hi[0]; r[5] = hi[1]; r[6] = hi[2]; r[7] = hi[3];
    return r;
}
__device__ __forceinline__ void seq_of(int t, int& start, int& len) {
    if (t < 16384) { start = 0; len = 16384; } else { start = 16384 + ((t - 16384) & ~8191); len = 8192; }
}
__device__ __forceinline__ const float* xrow(const Params& p, int r) { return r < 16384 ? p.x_prompt + (size_t)r * 1024 : p.x_sample + (size_t)(r - 16384) * 1024; }
__device__ __forceinline__ int padoff_of(int r) { return r < 16384 ? 1 : 129 + 192 * ((r - 16384) >> 13); }

namespace pg8 {
constexpr int BM = 256, BK = 64, HALF = 128, HTB = HALF * BK * 2, NXCD = 8, WGM = 8;
__host__ __device__ __forceinline__ int lds_byte(int r, int c) { const int st = (r >> 4) * 2 + (c >> 5), rr = r & 15, cc = c & 31, ob = rr * 64 + cc * 2; return st * 1024 + (ob ^ (((ob >> 9) & 1) << 5)); }
__host__ __device__ __forceinline__ void stage_rc(int b, int& R, int& C) { const int st = b / 1024, sb = b % 1024, swz = sb ^ (((sb >> 9) & 1) << 5); R = (st >> 1) * 16 + swz / 64; C = (st & 1) * 32 + (swz % 64) / 2; }
__host__ __device__ __forceinline__ int perm32(int rho) { const int n = rho >> 4, i = rho & 15; return 8 * (i >> 2) + 4 * n + (i & 3); }
struct Unit { int pm, pn; };
struct Sched {
    int nM, nN, nwg, G, c, mode;
    __device__ void init(int nM_, int nN_, int G_, int c_, int mode_) { nM = nM_; nN = nN_; nwg = nM * nN; G = G_; c = c_; mode = mode_; }
    __device__ bool next(int i, Unit& u) const {
        const long L = (long)i * G + c; if (L >= nwg) return false;
        int wgid = (int)L; { const int q = nwg / NXCD, r = nwg % NXCD, xcd = wgid % NXCD, off = wgid / NXCD; wgid = (xcd < r ? xcd * (q + 1) : r * (q + 1) + (xcd - r) * q) + off; }
        const int nig = WGM * nN, gid = wgid / nig, fm = gid * WGM, gsz = (nM - fm) < WGM ? (nM - fm) : WGM;
        u.pm = fm + ((wgid % nig) % gsz); u.pn = (wgid % nig) / gsz; return true;
    }
    __device__ __forceinline__ long arow(int pm) const {
        if (mode == 0) return (long)pm * 256;
        if (pm < 65) return (long)pm * 254;
        const int q = pm - 65; return 16512 + (long)(q / 33) * 8384 + (long)(q % 33) * 254;
    }
};

template <class Epi>
__device__ __forceinline__ void gemm_phase(LAS unsigned char* lds, const bf16_t* Ag, const bf16_t* Btg, const int K, const Sched& S, Epi& E) {
    const int tid = threadIdx.x, wid = __builtin_amdgcn_readfirstlane(tid >> 6), lane = tid & 63, wr = wid >> 2, wc = wid & 3, fr = lane & 15, fq = lane >> 4;
    const int nt = K / BK;
    unsigned voffA[2], voffB[2];
#pragma unroll
    for (int i = 0; i < 2; ++i) { int R, C; stage_rc(tid * 16 + i * 8192, R, C); const int Rb = Epi::PERM ? ((R & ~31) + perm32(R & 31)) : R;
        voffA[i] = (unsigned)(R * K + C) * 2u; voffB[i] = (unsigned)(Rb * K + C) * 2u; }
    const size_t kstep = (size_t)(BK * 2);
    const size_t hstep = (size_t)HALF * K * 2;
    const size_t tstep = 2 * hstep;
    const size_t rowb = (size_t)K * 2;
    const unsigned ldsw = (unsigned)wid * 1024u;
    const int aoff = lds_byte(wr * 64 + fr, fq * 8), boff = lds_byte(wc * 32 + fr, fq * 8);
#define PG8_SA(b, h) (((b) * 2 + (h)) * HTB)
#define PG8_SB(b, h) ((4 + (b) * 2 + (h)) * HTB)
#define PG8_STAGE(bufoff, gbase, voff) do { _Pragma("unroll") for (int _i = 0; _i < 2; ++_i) \
        __builtin_amdgcn_global_load_lds((const unsigned*)((const char*)(gbase) + (voff)[_i]), (LAS unsigned*)(lds + (bufoff) + ldsw + _i * 8192), 16, 0, 0); } while (0)
#define PG8_LDA(dst, b, h) do { _Pragma("unroll") for (int m = 0; m < 4; ++m) _Pragma("unroll") for (int k = 0; k < 2; ++k) dst[m][k] = *(const LAS bf16x8*)(lds + PG8_SA(b, h) + aoff + m * 2048 + k * 1024); } while (0)
#define PG8_LDB(dst, b, h) do { _Pragma("unroll") for (int n = 0; n < 2; ++n) _Pragma("unroll") for (int k = 0; k < 2; ++k) dst[n][k] = *(const LAS bf16x8*)(lds + PG8_SB(b, h) + boff + n * 2048 + k * 1024); } while (0)
#define PG8_MMA(ai, bj, At, Bt) do { __builtin_amdgcn_s_setprio(1); _Pragma("unroll") for (int m = 0; m < 4; ++m) _Pragma("unroll") for (int n = 0; n < 2; ++n) _Pragma("unroll") for (int k = 0; k < 2; ++k) \
        acc[ai][bj][m][n] = __builtin_amdgcn_mfma_f32_16x16x32_bf16(Bt[n][k], At[m][k], acc[ai][bj][m][n], 0, 0, 0); __builtin_amdgcn_s_setprio(0); } while (0)
#define PG8_WAIT_V(n) asm volatile("s_waitcnt vmcnt(" #n ")" ::: "memory")
#define PG8_WAIT_L(n) asm volatile("s_waitcnt lgkmcnt(" #n ")" ::: "memory")
#define PG8_BAR __builtin_amdgcn_s_barrier()
#define PG8_SCHED __builtin_amdgcn_sched_barrier(0)
    Unit cur, nxt; int ui = 0;
    if (!S.next(0, cur)) return;
    f32x4 acc[2][2][4][2];
#pragma unroll
    for (int a = 0; a < 2; ++a)
#pragma unroll
        for (int b = 0; b < 2; ++b)
#pragma unroll
            for (int m = 0; m < 4; ++m)
#pragma unroll
                for (int n = 0; n < 2; ++n) acc[a][b][m][n] = (f32x4){0.f, 0.f, 0.f, 0.f};
    bf16x8 At[4][2], B0[2][2], B1[2][2];
    const char* cA = (const char*)Ag + (size_t)S.arow(cur.pm) * rowb; const char* cB = (const char*)Btg + (size_t)cur.pn * tstep;
    PG8_STAGE(PG8_SB(0, 0), cB, voffB); PG8_STAGE(PG8_SA(0, 0), cA, voffA); PG8_STAGE(PG8_SB(0, 1), cB + hstep, voffB); PG8_STAGE(PG8_SA(0, 1), cA + hstep, voffA);
    if (wr == 1) PG8_BAR;
    PG8_WAIT_V(4); PG8_BAR;
    PG8_STAGE(PG8_SB(1, 0), cB + kstep, voffB); PG8_STAGE(PG8_SA(1, 0), cA + kstep, voffA); PG8_STAGE(PG8_SB(1, 1), cB + hstep + kstep, voffB);
    PG8_WAIT_V(6); PG8_BAR;
    for (;;) {
        const bool has_next = S.next(ui + 1, nxt);
        const char* nA = has_next ? (const char*)Ag + (size_t)S.arow(nxt.pm) * rowb : cA; const char* nB = has_next ? (const char*)Btg + (size_t)nxt.pn * tstep : cB;
        for (int t = 0; t < nt; t += 2) {
            const bool last = (t == nt - 2);
            const char* a1 = cA + (size_t)(t + 1) * kstep;
            const char* a2 = last ? nA : cA + (size_t)(t + 2) * kstep; const char* b2 = last ? nB : cB + (size_t)(t + 2) * kstep;
            const char* a3 = a2 + kstep; const char* b3 = b2 + kstep;
            if constexpr (Epi::MIDK) { if (t == (nt >> 1)) E.mid(acc, cur, wr, wc, fr, fq); }
            PG8_LDB(B0, 0, 0); PG8_SCHED; PG8_LDA(At, 0, 0); PG8_STAGE(PG8_SA(1, 1), a1 + hstep, voffA);
            PG8_WAIT_L(8); PG8_BAR; PG8_WAIT_L(0); PG8_MMA(0, 0, At, B0); PG8_BAR; PG8_SCHED;
            PG8_LDB(B1, 0, 1); PG8_STAGE(PG8_SB(0, 0), b2, voffB);
            PG8_BAR; PG8_WAIT_L(0); PG8_MMA(0, 1, At, B1); PG8_BAR;
            PG8_LDA(At, 0, 1); PG8_STAGE(PG8_SA(0, 0), a2, voffA);
            PG8_BAR; PG8_WAIT_L(0); PG8_MMA(1, 0, At, B0); PG8_BAR; PG8_SCHED;
            PG8_STAGE(PG8_SB(0, 1), b2 + hstep, voffB);
            PG8_WAIT_V(6); PG8_BAR; PG8_MMA(1, 1, At, B1); PG8_BAR;
            PG8_LDB(B0, 1, 0); PG8_SCHED; PG8_LDA(At, 1, 0); PG8_STAGE(PG8_SA(0, 1), a2 + hstep, voffA);
            PG8_WAIT_L(8); PG8_BAR; PG8_WAIT_L(0); PG8_MMA(0, 0, At, B0); PG8_BAR; PG8_SCHED;
            PG8_LDB(B1, 1, 1); PG8_STAGE(PG8_SB(1, 0), b3, voffB);
            PG8_BAR; PG8_WAIT_L(0); PG8_MMA(0, 1, At, B1); PG8_BAR;
            PG8_LDA(At, 1, 1); PG8_STAGE(PG8_SA(1, 0), a3, voffA);
            PG8_BAR; PG8_WAIT_L(0); PG8_MMA(1, 0, At, B0); PG8_BAR; PG8_SCHED;
            PG8_STAGE(PG8_SB(1, 1), b3 + hstep, voffB);
            PG8_WAIT_V(6); PG8_BAR; PG8_MMA(1, 1, At, B1); PG8_BAR;
        }
        E(acc, cur, wr, wc, fr, fq);
        if (!has_next) break;
#pragma unroll
        for (int a = 0; a < 2; ++a)
#pragma unroll
            for (int b = 0; b < 2; ++b)
#pragma unroll
                for (int m = 0; m < 4; ++m)
#pragma unroll
                    for (int n = 0; n < 2; ++n) acc[a][b][m][n] = (f32x4){0.f, 0.f, 0.f, 0.f};
        cur = nxt; cA = nA; cB = nB; ++ui;
    }
    PG8_WAIT_V(0);
    if (wr == 0) PG8_BAR;
    PG8_BAR;
#undef PG8_SA
#undef PG8_SB
#undef PG8_STAGE
#undef PG8_LDA
#undef PG8_LDB
#undef PG8_MMA
#undef PG8_WAIT_V
#undef PG8_WAIT_L
#undef PG8_BAR
#undef PG8_SCHED
}
}
using pg8::Unit;
typedef f32x4 AccT[2][2][4][2];

__device__ __forceinline__ unsigned opq0() { unsigned z; asm volatile("v_mov_b32 %0, 0" : "=v"(z)); return z; }
struct Epi1 {
    static constexpr bool PERM = true, MIDK = false;
    Params p;
    __device__ __forceinline__ void operator()(const AccT& acc, const Unit& u, int wr, int wc, int fr, int fq) const {
        const int pn = u.pn; const unsigned row0 = u.pm * 256 + wr * 64 + fr + opq0();
        if (pn <= 2) {
            int start, len; seq_of(u.pm * 256, start, len);
            const unsigned char* rotc = p.ws + OFF_ROTC; const unsigned char* rots = p.ws + OFF_ROTS;
            const unsigned dl = 16 * (wc & 1) + 4 * fq;
            unsigned char* b0; unsigned char* b1; unsigned ld, c0, c1;
            if (pn < 2) { b0 = p.ws + OFF_QH; b1 = b0; ld = 2048; c0 = (256 * pn + 32 * wc + 8 * fq) * 2; c1 = c0 + 256; }
            else { b0 = p.ws + OFF_K; b1 = p.ws + OFF_V; ld = 256; c0 = (32 * wc + 8 * fq) * 2; c1 = c0; }
#pragma unroll
            for (int ai = 0; ai < 2; ++ai) {
                f32x4 csv[4], snv[4];
#pragma unroll
                for (int m = 0; m < 4; ++m) { const unsigned pos = row0 + ai * 128 + m * 16 - start;
                    csv[m] = *(const f32x4*)(rotc + (unsigned)((pos * 32 + dl) * 4)); snv[m] = *(const f32x4*)(rots + (unsigned)((pos * 32 + dl) * 4)); }
#pragma unroll
                for (int m = 0; m < 4; ++m) {
                    const unsigned r = row0 + ai * 128 + m * 16;
                    const f32x4 cs = csv[m], sn = snv[m];
                    { const f32x4 v0 = acc[ai][0][m][0], v1 = acc[ai][0][m][1];
                      store8((bf16_t*)(b0 + (unsigned)(r * ld + c0)), v0 * cs - v1 * sn, v1 * cs + v0 * sn); }
                    { const f32x4 v0 = acc[ai][1][m][0], v1 = acc[ai][1][m][1];
                      if (pn == 2) store8((bf16_t*)(b1 + (unsigned)(r * ld + c1)), v0, v1);
                      else store8((bf16_t*)(b1 + (unsigned)(r * ld + c1)), v0 * cs - v1 * sn, v1 * cs + v0 * sn); }
                }
                asm volatile("" ::: "memory");
            }
        } else if (pn <= 4 || (pn >= 9 && pn <= 12)) {
            unsigned char* base; unsigned ld, cb;
            if (pn <= 4) { base = p.ws + OFF_QH; ld = 2048; cb = 512 + 256 * (pn - 3); }
            else if (pn <= 10) { base = p.ws + OFF_HI; ld = 1024; cb = 256 * (pn - 9); }
            else { base = p.ws + OFF_HG; ld = 1024; cb = 256 * (pn - 11); }
            const unsigned c0 = (cb + 32 * wc + 8 * fq) * 2;
            if (pn >= 11) {
#pragma unroll
                for (int ai = 0; ai < 2; ++ai)
#pragma unroll
                    for (int m = 0; m < 4; ++m) {
                        const unsigned r = row0 + ai * 128 + m * 16;
#pragma unroll
                        for (int bj = 0; bj < 2; ++bj) {
                            f32x4 v0 = acc[ai][bj][m][0], v1 = acc[ai][bj][m][1];
#pragma unroll
                            for (int e = 0; e < 4; ++e) { v0[e] = v0[e] * sigmoidf_(v0[e]); v1[e] = v1[e] * sigmoidf_(v1[e]); }
                            store8((bf16_t*)(base + (unsigned)(r * ld + c0 + 256 * bj)), v0, v1);
                        }
                        asm volatile("" ::: "memory");
                    }
            } else {
#pragma unroll
                for (int ai = 0; ai < 2; ++ai)
#pragma unroll
                    for (int m = 0; m < 4; ++m) {
                        const unsigned r = row0 + ai * 128 + m * 16;
#pragma unroll
                        for (int bj = 0; bj < 2; ++bj) store8((bf16_t*)(base + (unsigned)(r * ld + c0 + 256 * bj)), acc[ai][bj][m][0], acc[ai][bj][m][1]);
                        asm volatile("" ::: "memory");
                    }
            }
        } else {
            const int dir = (pn - 5) >> 1; const unsigned cb = 256 * ((pn - 5) & 1);
            unsigned char* base = p.ws + (dir ? OFF_GB : OFF_GF);
#pragma unroll
            for (int bj = 0; bj < 2; ++bj) {
                const unsigned col = cb + 128 * bj + 32 * wc + 8 * fq;
                float lb[8];
#pragma unroll
                for (int e = 0; e < 8; ++e) { const float l0 = p.lb_logits[dir * 512 + col + e], l1 = p.lb_logits[1024 + dir * 512 + col + e]; lb[e] = __builtin_amdgcn_rcpf(1.0f + __expf(l1 - l0)); }
#pragma unroll
                for (int ai = 0; ai < 2; ++ai)
#pragma unroll
                    for (int m = 0; m < 4; ++m) {
                        const unsigned r = row0 + ai * 128 + m * 16;
                        f32x4 v0 = acc[ai][bj][m][0], v1 = acc[ai][bj][m][1];
#pragma unroll
                        for (int e = 0; e < 4; ++e) {
                            v0[e] = __builtin_amdgcn_logf(lb[e] + (1.0f - lb[e]) * sigmoidf_(v0[e]));
                            v1[e] = __builtin_amdgcn_logf(lb[4 + e] + (1.0f - lb[4 + e]) * sigmoidf_(v1[e]));
                        }
                        store8((bf16_t*)(base + (unsigned)((r * 512 + col) * 2)), v0, v1);
                        asm volatile("" ::: "memory");
                    }
            }
        }
    }
};
struct EpiGate {
    static constexpr bool PERM = true, MIDK = false;
    Params p;
    __device__ __forceinline__ void operator()(const AccT& acc, const Unit& u, int wr, int wc, int fr, int fq) const {
        unsigned char* G = (unsigned char*)p.out; const unsigned row0 = u.pm * 256 + wr * 64 + fr + opq0();
        const unsigned c0 = (128 * u.pn + 32 * wc + 8 * fq) * 2;
#pragma unroll
        for (int ai = 0; ai < 2; ++ai)
#pragma unroll
            for (int m = 0; m < 4; ++m) {
                const unsigned r = row0 + ai * 128 + m * 16;
                f32x4 rt[2], sh[2];
#pragma unroll
                for (int n = 0; n < 2; ++n)
#pragma unroll
                    for (int e = 0; e < 4; ++e) {
                        const float ea = __builtin_amdgcn_exp2f(acc[ai][0][m][n][e] * -1.4426950408889634f), eh = __builtin_amdgcn_exp2f(acc[ai][1][m][n][e] * -1.4426950408889634f);
                        const float sga = __builtin_amdgcn_rcpf(1.0f + ea);
                        sh[n][e] = __builtin_amdgcn_rcpf(1.0f + eh); rt[n][e] = sga * (1.0f + eh);
                    }
                store8((bf16_t*)(G + (unsigned)(r * 4096 + c0)), rt[0], rt[1]);
                store8((bf16_t*)(G + (unsigned)(r * 4096 + 2048 + c0)), sh[0], sh[1]);
                asm volatile("" ::: "memory");
            }
    }
};
struct EpiMix {
    static constexpr bool PERM = true, MIDK = true;
    Params p;
    template <int OFFB> __device__ __forceinline__ void scale(AccT& acc, const Unit& u, int wr, int wc, int fr, int fq) const {
        const unsigned char* G = (const unsigned char*)p.out; const unsigned row0 = u.pm * 256 + wr * 64 + fr + opq0();
        const unsigned c0 = (256 * u.pn + 32 * wc + 8 * fq) * 2 + OFFB;
#pragma unroll
        for (int ai = 0; ai < 2; ++ai) {
            u32x4 g[4][2];
#pragma unroll
            for (int m = 0; m < 4; ++m)
#pragma unroll
                for (int bj = 0; bj < 2; ++bj) g[m][bj] = *(const u32x4*)(G + (unsigned)((row0 + ai * 128 + m * 16) * 4096 + c0 + 256 * bj));
#pragma unroll
            for (int m = 0; m < 4; ++m)
#pragma unroll
                for (int bj = 0; bj < 2; ++bj) {
                    const u32x4 v = g[m][bj];
                    acc[ai][bj][m][0][0] *= bflo(v[0]); acc[ai][bj][m][0][1] *= bfhi(v[0]); acc[ai][bj][m][0][2] *= bflo(v[1]); acc[ai][bj][m][0][3] *= bfhi(v[1]);
                    acc[ai][bj][m][1][0] *= bflo(v[2]); acc[ai][bj][m][1][1] *= bfhi(v[2]); acc[ai][bj][m][1][2] *= bflo(v[3]); acc[ai][bj][m][1][3] *= bfhi(v[3]);
                }
            asm volatile("" ::: "memory");
        }
    }
    __device__ __forceinline__ void mid(AccT& acc, const Unit& u, int wr, int wc, int fr, int fq) const { scale<0>(acc, u, wr, wc, fr, fq); }
    __device__ __forceinline__ void operator()(AccT& acc, const Unit& u, int wr, int wc, int fr, int fq) const {
        scale<2048>(acc, u, wr, wc, fr, fq);
        unsigned char* MX = p.ws + OFF_MIXED; const unsigned row0 = u.pm * 256 + wr * 64 + fr + opq0();
        const unsigned c0 = (256 * u.pn + 32 * wc + 8 * fq) * 2;
#pragma unroll
        for (int ai = 0; ai < 2; ++ai)
#pragma unroll
            for (int m = 0; m < 4; ++m)
#pragma unroll
                for (int bj = 0; bj < 2; ++bj)
                    store8((bf16_t*)(MX + (unsigned)((row0 + ai * 128 + m * 16) * 2048 + c0 + 256 * bj)), acc[ai][bj][m][0], acc[ai][bj][m][1]);
    }
};
struct EpiX1 {
    static constexpr bool PERM = true, MIDK = false;
    Params p;
    __device__ __forceinline__ void operator()(const AccT& acc, const Unit& u, int wr, int wc, int fr, int fq) const {
        const unsigned row0 = u.pm * 256 + wr * 64 + fr + opq0(); const unsigned po = padoff_of(u.pm * 256);
        unsigned char* XB = p.ws + OFF_H; float* ss = (float*)(p.ws + OFF_SS1);
        const bool pr = u.pm < 64; const unsigned char* xb = (const unsigned char*)(pr ? p.x_prompt : p.x_sample); const unsigned xr0 = pr ? 0u : 16384u;
        const unsigned c0 = 256 * u.pn + 32 * wc + 8 * fq;
#pragma unroll
        for (int ai = 0; ai < 2; ++ai) {
            f32x4 xv[4][2][2];
#pragma unroll
            for (int m = 0; m < 4; ++m)
#pragma unroll
                for (int bj = 0; bj < 2; ++bj) { const unsigned char* xp = xb + (unsigned)(((row0 + ai * 128 + m * 16 - xr0) * 1024 + c0 + 128 * bj) * 4);
                    xv[m][bj][0] = *(const f32x4*)xp; xv[m][bj][1] = *(const f32x4*)(xp + 16); }
#pragma unroll
            for (int m = 0; m < 4; ++m) {
                const unsigned r = row0 + ai * 128 + m * 16; float s = 0.f;
#pragma unroll
                for (int bj = 0; bj < 2; ++bj) {
                    const unsigned c = c0 + 128 * bj;
                    const f32x4 v0 = acc[ai][bj][m][0] + xv[m][bj][0], v1 = acc[ai][bj][m][1] + xv[m][bj][1];
                    store8((bf16_t*)(XB + (unsigned)(((r + po) * 1024 + c) * 2)), v0, v1);
#pragma unroll
                    for (int e = 0; e < 4; ++e) s += v0[e] * v0[e] + v1[e] * v1[e];
                }
                s += __shfl_xor(s, 16); s += __shfl_xor(s, 32);
                if (fq == 0) atomicAdd(ss + r, s);
            }
            asm volatile("" ::: "memory");
        }
    }
};
struct EpiDown {
    static constexpr bool PERM = true, MIDK = false;
    Params p;
    __device__ __forceinline__ void operator()(const AccT& acc, const Unit& u, int wr, int wc, int fr, int fq) const {
        const unsigned row0 = u.pm * 256 + wr * 64 + fr + opq0(); float* ss = (float*)(p.ws + OFF_SS2); unsigned char* XB = p.ws + OFF_H;
        const unsigned po = padoff_of(u.pm * 256);
        const unsigned c0 = (256 * u.pn + 32 * wc + 8 * fq) * 2;
#pragma unroll
        for (int ai = 0; ai < 2; ++ai) {
            u32x4 xv[4][2];
#pragma unroll
            for (int m = 0; m < 4; ++m)
#pragma unroll
                for (int bj = 0; bj < 2; ++bj) xv[m][bj] = *(const u32x4*)(XB + (unsigned)((row0 + ai * 128 + m * 16 + po) * 2048 + c0 + 256 * bj));
#pragma unroll
            for (int m = 0; m < 4; ++m) {
                const unsigned r = row0 + ai * 128 + m * 16; float s = 0.f;
#pragma unroll
                for (int bj = 0; bj < 2; ++bj) {
                    const u32x4 x = xv[m][bj];
                    f32x4 v0 = acc[ai][bj][m][0], v1 = acc[ai][bj][m][1];
                    v0[0] += bflo(x[0]); v0[1] += bfhi(x[0]); v0[2] += bflo(x[1]); v0[3] += bfhi(x[1]);
                    v1[0] += bflo(x[2]); v1[1] += bfhi(x[2]); v1[2] += bflo(x[3]); v1[3] += bfhi(x[3]);
                    store8((bf16_t*)(XB + (unsigned)((r + po) * 2048 + c0 + 256 * bj)), v0, v1);
#pragma unroll
                    for (int e = 0; e < 4; ++e) s += v0[e] * v0[e] + v1[e] * v1[e];
                }
                s += __shfl_xor(s, 16); s += __shfl_xor(s, 32);
                if (fq == 0) atomicAdd(ss + r, s);
            }
            asm volatile("" ::: "memory");
        }
    }
};
__device__ __forceinline__ float dpp_ror1(float v) { return __int_as_float(__builtin_amdgcn_mov_dpp(__float_as_int(v), 0x121, 0xf, 0xf, true)); }
__device__ __forceinline__ float dpp_ror15(float v) { return __int_as_float(__builtin_amdgcn_mov_dpp(__float_as_int(v), 0x12F, 0xf, 0xf, true)); }
struct EpiUp {
    static constexpr bool PERM = true, MIDK = false;
    Params p; LAS unsigned char* exch;
    __device__ __forceinline__ void operator()(AccT& acc, const Unit& u, int wr, int wc, int fr, int fq) const {
        int seq, ti; if (u.pm < 65) { seq = 0; ti = u.pm; } else { const int q = u.pm - 65; seq = 1 + q / 33; ti = q % 33; }
        const int start = seq == 0 ? 0 : 16384 + 8192 * (seq - 1), len = seq == 0 ? 16384 : 8192;
        const unsigned char* ss = p.ws + OFF_SS1;
        unsigned char* ACT = p.ws + OFF_ACT;
        LAS float* ex = (LAS float*)exch;
        const int R0 = 64 * wr + fr + (int)opq0(); const int pos0 = 254 * ti + R0 - 1;
        const unsigned char* cwp = (const unsigned char*)p.conv_w; const unsigned char* cbp = (const unsigned char*)p.conv_b;
        const unsigned jb = 128 * u.pn + 32 * wc + 8 * fq + opq0();
        f32x4 cwv[2][4];
#pragma unroll
        for (int bj = 0; bj < 2; ++bj) { const unsigned col = bj * DFF + jb;
            cwv[bj][0] = *(const f32x4*)(cwp + (unsigned)(col * 4)); cwv[bj][1] = *(const f32x4*)(cwp + (unsigned)((5632 + col) * 4));
            cwv[bj][2] = *(const f32x4*)(cwp + (unsigned)((2 * 5632 + col) * 4)); cwv[bj][3] = *(const f32x4*)(cbp + (unsigned)(col * 4)); }
#pragma unroll
        for (int ai = 0; ai < 2; ++ai)
#pragma unroll
            for (int m = 0; m < 4; ++m) {
                const int pos = pos0 + 128 * ai + 16 * m;
                float rs = 0.f; if (pos >= 0 && pos < len) rs = rsqrtf(*(const float*)(ss + (unsigned)((start + pos) * 4)) * (1.0f / 1024.0f) + EPS);
#pragma unroll
                for (int bj = 0; bj < 2; ++bj)
#pragma unroll
                    for (int n = 0; n < 2; ++n) acc[ai][bj][m][n] *= rs;
            }
        const int clb = 32 * wc + 8 * fq + (int)opq0();
        const bool fr0 = (fr == 0), fr15 = (fr == 15);
#pragma unroll
        for (int ai = 0; ai < 2; ++ai) {
            const int seg = 2 * ai + wr;
#pragma unroll
            for (int bj = 0; bj < 2; ++bj)
#pragma unroll
                for (int n = 0; n < 2; ++n) {
                    const int cl = 128 * bj + clb + 4 * n;
                    if (fr == 0) *(LAS f32x4*)(ex + (seg * 2 + 0) * 256 + cl) = acc[ai][bj][0][n];
                    if (fr == 15) *(LAS f32x4*)(ex + (seg * 2 + 1) * 256 + cl) = acc[ai][bj][3][n];
                }
        }
        asm volatile("s_waitcnt lgkmcnt(0)" ::: "memory");
        __builtin_amdgcn_s_barrier(); __builtin_amdgcn_s_barrier();
        asm volatile("" ::: "memory");
#pragma unroll
        for (int n = 0; n < 2; ++n) {
            const unsigned jc = 128 * u.pn + clb + 4 * n;
            if (n == 1) {
#pragma unroll
                for (int bj = 0; bj < 2; ++bj) { const unsigned col = bj * DFF + jb + 4;
                    cwv[bj][0] = *(const f32x4*)(cwp + (unsigned)(col * 4)); cwv[bj][1] = *(const f32x4*)(cwp + (unsigned)((5632 + col) * 4));
                    cwv[bj][2] = *(const f32x4*)(cwp + (unsigned)((2 * 5632 + col) * 4)); cwv[bj][3] = *(const f32x4*)(cbp + (unsigned)(col * 4)); }
            }
#pragma unroll
            for (int ai = 0; ai < 2; ++ai) {
                const int seg = 2 * ai + wr;
                f32x4 val[4];
#pragma unroll
                for (int bj = 0; bj < 2; ++bj) {
                    const f32x4 cw0 = cwv[bj][0], cw1 = cwv[bj][1], cw2 = cwv[bj][2], cbv = cwv[bj][3];
                    const int cl = 128 * bj + clb + 4 * n;
                    f32x4 prevlast = (f32x4){0.f, 0.f, 0.f, 0.f}, nextfirst = (f32x4){0.f, 0.f, 0.f, 0.f};
                    if (seg > 0) prevlast = *(LAS f32x4*)(ex + ((seg - 1) * 2 + 1) * 256 + cl);
                    if (seg < 3) nextfirst = *(LAS f32x4*)(ex + ((seg + 1) * 2 + 0) * 256 + cl);
#pragma unroll
                    for (int m = 0; m < 4; ++m) {
                        f32x4 up, dn;
#pragma unroll
                        for (int e = 0; e < 4; ++e) {
                            const float cur = acc[ai][bj][m][n][e];
                            const float pv = m > 0 ? acc[ai][bj][m > 0 ? m - 1 : 0][n][e] : prevlast[e];
                            const float nx = m < 3 ? acc[ai][bj][m < 3 ? m + 1 : 3][n][e] : nextfirst[e];
                            up[e] = dpp_ror1(fr15 ? pv : cur);
                            dn[e] = dpp_ror15(fr0 ? nx : cur);
                        }
                        const f32x4 res = cw0 * up + cw1 * acc[ai][bj][m][n] + cw2 * dn + cbv;
                        if (bj == 0) val[m] = res;
                        else {
                            const int R = 128 * ai + 16 * m + R0; const int pos = pos0 + 128 * ai + 16 * m;
                            if (R >= 1 && R <= 254 && pos < len) {
                                f32x4 o;
#pragma unroll
                                for (int e = 0; e < 4; ++e) { const float g = res[e]; o[e] = g * sigmoidf_(g) * val[m][e]; }
                                *(u32x2*)(ACT + (unsigned)(((start + pos) * DFF + jc) * 2)) = pack4(o);
                            }
                        }
                        __builtin_amdgcn_sched_barrier(0);
                    }
                    asm volatile("" ::: "memory");
                }
            }
        }
    }
};

template <class ColMap>
__device__ __forceinline__ void conv_weight(bf16_t* dst, int Nd, int K, const ColMap& cm, int gtid, int gthreads) {
    const int kc_n = K / 8; const long total = (long)Nd * kc_n;
    for (long ci = gtid; ci < total; ci += gthreads) {
        const int kc = (int)(ci / Nd), n = (int)(ci % Nd);
        float v[8];
#pragma unroll
        for (int e = 0; e < 8; ++e) v[e] = cm(n, kc * 8 + e);
        u32x4 o; o[0] = pk_bf16(v[0], v[1]); o[1] = pk_bf16(v[2], v[3]); o[2] = pk_bf16(v[4], v[5]); o[3] = pk_bf16(v[6], v[7]);
        *(u32x4*)(dst + (size_t)n * K + kc * 8) = o;
    }
}
__device__ void phase_prep(const Params& p) {
    const int gtid = blockIdx.x * blockDim.x + threadIdx.x, gthreads = gridDim.x * blockDim.x;
    unsigned char* ws = p.ws;
    {
        const float* w = p.w_in; const float* nw = p.norm_mix_w;
        auto cm = [=](int n, int k) -> float {
            int col = n; float sc = nw[k];
            if (n < 640) { const int hd = n >> 6, q = n & 63; const int d = 16 * (q >> 5) + 4 * ((q & 31) >> 3) + (q & 3) + 32 * ((q & 7) >> 2); col = 64 * hd + d; if (n < 512) sc *= 0.125f * 1.4426950408889634f; }
            else if (n >= 3328) { const int t = n - 3328, tile = t >> 8, r = t & 255; col = r < 128 ? 3328 + 128 * tile + r : 4352 + 128 * tile + (r - 128); }
            return w[(size_t)k * DIN + col] * sc; };
        conv_weight((bf16_t*)(ws + OFF_WIN), DIN, 1024, cm, gtid, gthreads);
    }
    {   const float* wa = p.w_attn_out; const float* wh = p.w_hgrn_out;
        auto cm = [=](int n, int k) -> float { return k < 512 ? wa[(size_t)k * 1024 + n] : wh[(size_t)(k - 512) * 1024 + n]; };
        conv_weight((bf16_t*)(ws + OFF_WCAT), 1024, 1024, cm, gtid, gthreads); }
    {   const float* w = p.w_mix_out;
        auto cm = [=](int n, int k) -> float { return w[(size_t)k * 1024 + n]; };
        conv_weight((bf16_t*)(ws + OFF_WMIX), 1024, 1024, cm, gtid, gthreads); }
    {   const float* w = p.w_up; const float* nw = p.norm_ffn_w;
        auto cm = [=](int n, int k) -> float { const int tile = n >> 8, r = n & 255; const int col = r < 128 ? 128 * tile + r : DFF + 128 * tile + (r - 128); return w[(size_t)k * 5632 + col] * nw[k]; };
        conv_weight((bf16_t*)(ws + OFF_WUP), 5632, 1024, cm, gtid, gthreads); }
    {   const float* w = p.w_down;
        auto cm = [=](int n, int k) -> float { return w[(size_t)k * 1024 + n]; };
        conv_weight((bf16_t*)(ws + OFF_WDN), 1024, DFF, cm, gtid, gthreads); }
    {   float* rc = (float*)(ws + OFF_ROTC); float* rsn = (float*)(ws + OFF_ROTS);
        for (int i = gtid; i < 16384 * 32; i += gthreads) {
            const int pos = i >> 5, k = i & 31;
            const double f = exp(-(double)k * (9.210340371976184 / 32.0));
            const double ang = (double)pos * f;
            const double kk = rint(ang * 0.15915494309189535);
            double r = fma(-kk, 6.283185307179586, ang); r = fma(-kk, 2.4492935982947064e-16, r);
            const float rf = (float)r;
            rc[i] = __cosf(rf); rsn[i] = __sinf(rf);
        } }
    {   float* s1 = (float*)(ws + OFF_SS1);
        for (int i = gtid; i < 2 * T_TOK; i += gthreads) s1[i] = 0.f; }
    {   const int wv = gtid >> 6, nwv = gthreads >> 6, lane = threadIdx.x & 63;
        bf16_t* H = (bf16_t*)(ws + OFF_H);
        for (int r = 2 * wv; r < T_TOK; r += 2 * nwv) {
            f32x4 v[2][4]; float s[2] = {0.f, 0.f};
#pragma unroll
            for (int q = 0; q < 2; ++q) { const float* xr = xrow(p, r + q);
#pragma unroll
                for (int i = 0; i < 4; ++i) v[q][i] = __builtin_nontemporal_load((const f32x4*)(xr + i * 256 + lane * 4)); }
#pragma unroll
            for (int q = 0; q < 2; ++q) {
#pragma unroll
                for (int i = 0; i < 4; ++i)
#pragma unroll
                    for (int e = 0; e < 4; ++e) s[q] += v[q][i][e] * v[q][i][e];
#pragma unroll
                for (int o = 32; o >= 1; o >>= 1) s[q] += __shfl_xor(s[q], o);
                const float rs = rsqrtf(s[q] * (1.0f / 1024.0f) + EPS);
#pragma unroll
                for (int i = 0; i < 4; ++i) *(u32x2*)(H + (size_t)(r + q) * 1024 + i * 256 + lane * 4) = pack4(v[q][i] * rs);
            }
        } }
}

__device__ void attn_item(LAS unsigned char* lds, const Params& p, int item, bf16_t* obase, int old_) {
    const int tid = threadIdx.x, wid = tid >> 6, lane = tid & 63, fr = lane & 15, fq = lane >> 4;
    const int g = item & 1, blk = item >> 1, t0 = blk * 128;
    int start, len; seq_of(t0, start, len);
    constexpr int KS = 144, NROW = 400;
    LAS unsigned char* Kt = lds; LAS unsigned char* Vt = lds + NROW * KS;
    const bf16_t* Kg = (const bf16_t*)(p.ws + OFF_K); const bf16_t* Vg = (const bf16_t*)(p.ws + OFF_V);
    bf16_t* QH = (bf16_t*)(p.ws + OFF_QH);
    for (int c = tid; c < NROW * 8; c += 512) {
        const int row = c >> 3, ch = c & 7; const int tk = t0 - 128 + row;
        u32x4 kv = (u32x4){0u, 0u, 0u, 0u}, vv = (u32x4){0u, 0u, 0u, 0u};
        if (row < 384 && tk >= start && tk < start + len) { kv = *(const u32x4*)(Kg + (size_t)tk * 128 + 64 * g + 8 * ch); vv = *(const u32x4*)(Vg + (size_t)tk * 128 + 64 * g + 8 * ch); }
        *(LAS u32x4*)(Kt + row * KS + ch * 16) = kv; *(LAS u32x4*)(Vt + row * KS + ch * 16) = vv;
    }
    __syncthreads();
    const int hh = wid >> 1, half = wid & 1, head = 4 * g + hh;
    const float sink2 = p.attn_sink[head] * 1.4426950408889634f;
    for (int qg = 0; qg < 4; ++qg) {
        const int tq0 = 64 * half + 16 * qg, nb0 = tq0 >> 4;
        const bf16_t* qp = QH + (size_t)(t0 + tq0 + fr) * 1024 + 64 * head + 8 * fq;
        const bf16x8 qf0 = *(const bf16x8*)qp, qf1 = *(const bf16x8*)(qp + 32);
        f32x4 st[18];
        const bool firstb = (t0 == start), lastb = (t0 + 128 == start + len);
#pragma unroll
        for (int nbr = 0; nbr < 17; ++nbr) {
            const LAS unsigned char* kr = Kt + (16 * (nb0 + nbr) + fr) * KS + 16 * fq;
            const bf16x8 k0 = *(const LAS bf16x8*)kr, k1 = *(const LAS bf16x8*)(kr + 64);
            f32x4 a = (f32x4){0.f, 0.f, 0.f, 0.f};
            a = mfma16(k0, qf0, a); a = mfma16(k1, qf1, a);
            st[nbr] = a;
        }
        float mx = sink2;
#pragma unroll
        for (int nbr = 0; nbr < 17; ++nbr) {
            const int nb = nb0 + nbr;
            if ((firstb && nb < 8) || (lastb && nb >= 16)) st[nbr] = (f32x4){-INFINITY, -INFINITY, -INFINITY, -INFINITY};
            if (nbr == 0) {
#pragma unroll
                for (int j = 0; j < 4; ++j) st[nbr][j] = (4 * fq + j >= fr) ? st[nbr][j] : -INFINITY;
            }
            if (nbr == 16) {
#pragma unroll
                for (int j = 0; j < 4; ++j) st[nbr][j] = (4 * fq + j <= fr) ? st[nbr][j] : -INFINITY;
            }
#pragma unroll
            for (int j = 0; j < 4; ++j) mx = fmaxf(mx, st[nbr][j]);
        }
        mx = fmaxf(mx, __shfl_xor(mx, 16)); mx = fmaxf(mx, __shfl_xor(mx, 32));
        float l = 0.f;
#pragma unroll
        for (int nbr = 0; nbr < 17; ++nbr)
#pragma unroll
            for (int j = 0; j < 4; ++j) { const float e = __builtin_amdgcn_exp2f(st[nbr][j] - mx); st[nbr][j] = e; l += e; }
        st[17] = (f32x4){0.f, 0.f, 0.f, 0.f};
        l += __shfl_xor(l, 16); l += __shfl_xor(l, 32); l += __builtin_amdgcn_exp2f(sink2 - mx);
        const float inv = 1.0f / l;
        f32x4 ot[4];
#pragma unroll
        for (int db = 0; db < 4; ++db) ot[db] = (f32x4){0.f, 0.f, 0.f, 0.f};
#pragma unroll
        for (int i = 0; i < 9; ++i) {
            bf16x8 pf; { const unsigned a0 = pk_bf16(st[2 * i][0], st[2 * i][1]), a1 = pk_bf16(st[2 * i][2], st[2 * i][3]), b0 = pk_bf16(st[2 * i + 1][0], st[2 * i + 1][1]), b1 = pk_bf16(st[2 * i + 1][2], st[2 * i + 1][3]);
                u32x4 t; t[0] = a0; t[1] = a1; t[2] = b0; t[3] = b1; pf = __builtin_bit_cast(bf16x8, t); }
            const int rowA = 16 * (nb0 + 2 * i) + 4 * fq;
#pragma unroll
            for (int db = 0; db < 4; ++db) {
                const bf16x8 vf = tr_frag(Vt, KS, rowA, rowA + 16, 16 * db, fr);
                ot[db] = mfma16(vf, pf, ot[db]);
            }
        }
        bf16_t* op = obase + (size_t)(t0 + tq0 + fr) * old_ + 64 * head + 4 * fq;
#pragma unroll
        for (int db = 0; db < 4; ++db) *(u32x2*)(op + 16 * db) = pack4(ot[db] * inv);
    }
    __syncthreads();
}

constexpr int TS = 272;
__device__ __forceinline__ void stage_tile64(LAS unsigned char* dst, const bf16_t* src, int ld, int tid) {
#pragma unroll
    for (int i = 0; i < 2; ++i) { const int c = tid + i * 512; const int row = c >> 4, ch = c & 15;
        *(LAS u32x4*)(dst + row * TS + ch * 16) = *(const u32x4*)(src + (size_t)row * ld + ch * 8); }
}
__device__ __forceinline__ void cumsum_T(const LAS unsigned char* Gt, int dir, int w, int fr, int fq, f32x4 (&bT)[4]) {
    bf16x8 gfrag[2];
#pragma unroll
    for (int ks = 0; ks < 2; ++ks) gfrag[ks] = tr_frag(Gt, TS, 32 * ks + 8 * fq, 32 * ks + 8 * fq + 4, 16 * w, fr);
#pragma unroll
    for (int ib = 0; ib < 4; ++ib) {
        f32x4 a = (f32x4){0.f, 0.f, 0.f, 0.f};
#pragma unroll
        for (int ks = 0; ks < 2; ++ks) {
            bf16x8 L; const int i = 16 * ib + fr;
#pragma unroll
            for (int e = 0; e < 8; ++e) { const int j = 32 * ks + 8 * fq + e; const bool on = dir ? (j >= i) : (j <= i); L[e] = on ? (short)0x3F80 : (short)0; }
            a = mfma16(gfrag[ks], L, a);
        }
        bT[ib] = a;
    }
}
__device__ __forceinline__ f32x4 bcast4(const f32x4& v, int srclane) { f32x4 r;
#pragma unroll
    for (int e = 0; e < 4; ++e) r[e] = __shfl(v[e], srclane); return r; }
__device__ __forceinline__ f32x4 exp4(f32x4 a) { f32x4 r;
#pragma unroll
    for (int e = 0; e < 4; ++e) r[e] = __builtin_amdgcn_exp2f(a[e]); return r; }

struct Tile3 { u32x4 r[6]; };
__device__ __forceinline__ void tiles_load(Tile3& t, const Params& p, int item, int tid) {
    const int h = item & 3, t0 = (item >> 2) * 64;
    const unsigned char* src[3] = { p.ws + OFF_GF, p.ws + OFF_GB, p.ws + OFF_HI };
#pragma unroll
    for (int k = 0; k < 3; ++k)
#pragma unroll
        for (int i = 0; i < 2; ++i) { const int c = tid + i * 512; const int row = c >> 4, ch = c & 15;
            t.r[2 * k + i] = *(const u32x4*)(src[k] + (unsigned)(((t0 + row) * 512 + 128 * h + ch * 8) * 2)); }
}
__device__ __forceinline__ void tiles_store(LAS unsigned char* lds, const Tile3& t, int tid) {
#pragma unroll
    for (int k = 0; k < 3; ++k)
#pragma unroll
        for (int i = 0; i < 2; ++i) { const int c = tid + i * 512; const int row = c >> 4, ch = c & 15;
            *(LAS u32x4*)(lds + k * 64 * TS + row * TS + ch * 16) = t.r[2 * k + i]; }
}
__device__ __forceinline__ void hgrn_u_compute(LAS unsigned char* lds, const Params& p, int item) {
    const int tid = threadIdx.x, w = tid >> 6, lane = tid & 63, fr = lane & 15, fq = lane >> 4;
    const int h = item & 3, cg_ = item >> 2;
    LAS unsigned char* Gt0 = lds; LAS unsigned char* Gt1 = lds + 64 * TS; LAS unsigned char* Vt = lds + 2 * 64 * TS; LAS unsigned char* Kd0 = lds + 3 * 64 * TS;
    bf16_t* ST = (bf16_t*)p.out; float* DC = (float*)(p.ws + OFF_DC);
#pragma unroll
    for (int dir = 0; dir < 2; ++dir) {
        const LAS unsigned char* Gt = dir ? Gt1 : Gt0; LAS unsigned char* Kd = Kd0 + dir * 64 * TS;
        f32x4 bT[4]; cumsum_T(Gt, dir, w, fr, fq, bT);
        const f32x4 blast = dir ? bcast4(bT[0], 16 * fq) : bcast4(bT[3], 16 * fq + 15);
        const f32x4 bref = dir ? bcast4(bT[2], 16 * fq) : bcast4(bT[1], 16 * fq + 15);
        if (fr == 0) { const f32x4 dcv = exp4(blast), erv = exp4(bref);
                       u32x4 rec; rec[0] = pk_bf16(dcv[0], dcv[1]); rec[1] = pk_bf16(dcv[2], dcv[3]); rec[2] = pk_bf16(erv[0], erv[1]); rec[3] = pk_bf16(erv[2], erv[3]);
                       *(u32x4*)((unsigned char*)DC + ((size_t)(cg_ * 4 + h) * 2 + dir) * 512 + (4 * w + fq) * 16) = rec; }
#pragma unroll
        for (int ib = 0; ib < 4; ++ib) {
            const int i = 16 * ib + fr;
            const f32x4 gv = load4bf_lds(Gt + i * TS + (16 * w + 4 * fq) * 2);
            f32x4 kd;
#pragma unroll
            for (int e = 0; e < 4; ++e) kd[e] = (1.0f - __builtin_amdgcn_exp2f(gv[e])) * __builtin_amdgcn_exp2f(blast[e] - bT[ib][e]);
            *(LAS u32x2*)(Kd + i * TS + (16 * w + 4 * fq) * 2) = pack4(kd);
        }
    }
    asm volatile("s_waitcnt lgkmcnt(0)" ::: "memory");
    bf16x8 kf[2][2];
#pragma unroll
    for (int dir = 0; dir < 2; ++dir)
#pragma unroll
        for (int ks = 0; ks < 2; ++ks) kf[dir][ks] = tr_frag(Kd0 + dir * 64 * TS, TS, 32 * ks + 8 * fq, 32 * ks + 8 * fq + 4, 16 * w, fr);
    bf16_t* dst = ST + ((size_t)(cg_ * 4 + h) * 2) * 16384;
#pragma unroll
    for (int jb = 0; jb < 8; ++jb) {
        f32x4 a0 = (f32x4){0.f, 0.f, 0.f, 0.f}, a1 = (f32x4){0.f, 0.f, 0.f, 0.f};
#pragma unroll
        for (int ks = 0; ks < 2; ++ks) { const bf16x8 vf = tr_frag(Vt, TS, 32 * ks + 8 * fq, 32 * ks + 8 * fq + 4, 16 * jb, fr); a0 = mfma16(kf[0][ks], vf, a0); a1 = mfma16(kf[1][ks], vf, a1); }
        bf16_t* q = dst + (size_t)(16 * jb + fr) * 128 + 16 * w + 4 * fq;
        *(u32x2*)q = pack4(a0); *(u32x2*)(q + 16384) = pack4(a1);
    }
}

__device__ void hgrn_u_pass(LAS unsigned char* lds, const Params& p, int c, int G) {
    const int tid = threadIdx.x; Tile3 t; int it = c;
    if (it < 3072) tiles_load(t, p, it, tid);
    for (; it < 3072; it += G) {
        tiles_store(lds, t, tid);
        __syncthreads();
        if (it + G < 3072) tiles_load(t, p, it + G, tid);
        hgrn_u_compute(lds, p, it);
        __syncthreads();
    }
}

__device__ void hgrn_scan_item(const Params& p, int item) {
    int chain, slice; if (item < 64) { chain = item >> 3; slice = item & 7; } else { chain = 8 + ((item - 64) >> 3); slice = item & 7; }
    int seq, hd; if (chain < 8) { seq = 0; hd = chain; } else { seq = 1 + ((chain - 8) >> 3); hd = (chain - 8) & 7; }
    const int h = hd >> 1, dir = hd & 1;
    const int c0 = seq == 0 ? 0 : 256 + 128 * (seq - 1), n = seq == 0 ? 256 : 128;
    const int e4 = slice * 512 + threadIdx.x;
    const int dk4 = (e4 & 31) * 4;
    bf16_t* ST = (bf16_t*)p.out; const float* DC = (const float*)(p.ws + OFF_DC);
    f32x4 s = (f32x4){0.f, 0.f, 0.f, 0.f};
    u32x2 uu[2][8]; u32x4 de[2][8];
#define SCAN_LOAD(B, CC) do { _Pragma("unroll") for (int k = 0; k < 8; ++k) { \
        const int c = dir ? (c0 + n - 1 - ((CC) + k)) : (c0 + (CC) + k); const size_t slot = ((size_t)(c * 4 + h) * 2 + dir); \
        uu[B][k] = *(const u32x2*)(ST + slot * 16384 + (size_t)e4 * 4); \
        de[B][k] = *(const u32x4*)((const unsigned char*)DC + slot * 512 + (size_t)(e4 & 31) * 16); } } while (0)
#define SCAN_STEP(B, CC) do { _Pragma("unroll") for (int k = 0; k < 8; ++k) { \
        const int c = dir ? (c0 + n - 1 - ((CC) + k)) : (c0 + (CC) + k); const size_t slot = ((size_t)(c * 4 + h) * 2 + dir); \
        f32x4 dd, er; dd[0] = bflo(de[B][k][0]); dd[1] = bfhi(de[B][k][0]); dd[2] = bflo(de[B][k][1]); dd[3] = bfhi(de[B][k][1]); \
        er[0] = bflo(de[B][k][2]); er[1] = bfhi(de[B][k][2]); er[2] = bflo(de[B][k][3]); er[3] = bfhi(de[B][k][3]); \
        *(u32x2*)(ST + slot * 16384 + (size_t)e4 * 4) = pack4(s * er);     \
        f32x4 u; u[0] = bflo(uu[B][k][0]); u[1] = bfhi(uu[B][k][0]); u[2] = bflo(uu[B][k][1]); u[3] = bfhi(uu[B][k][1]); \
        s = dd * s + u; } } while (0)
    SCAN_LOAD(0, 0);
    for (int cc = 0; cc < n; cc += 16) {
        SCAN_LOAD(1, cc + 8);
        SCAN_STEP(0, cc);
        if (cc + 16 < n) SCAN_LOAD(0, cc + 16);
        SCAN_STEP(1, cc + 8);
    }
#undef SCAN_LOAD
#undef SCAN_STEP
}

__device__ __forceinline__ void hgrn_o_compute(LAS unsigned char* lds, const Params& p, int item, bf16_t* obase, int old_, Tile3& tn, int nxt) {
    const int tid = threadIdx.x, w = tid >> 6, lane = tid & 63, fr = lane & 15, fq = lane >> 4;
    const int h = item & 3, cg_ = item >> 2, t0 = cg_ * 64;
    LAS unsigned char* Gt0 = lds; LAS unsigned char* Gt1 = lds + 64 * TS; LAS unsigned char* Vt = lds + 2 * 64 * TS;
    LAS unsigned char* QK = lds + 3 * 64 * TS;
    constexpr int AS = 144;
    LAS unsigned char* AtB = lds + 7 * 64 * TS;
    LAS float* red = (LAS float*)lds;
    bf16_t* QH = (bf16_t*)(p.ws + OFF_QH);
    const bf16_t* ST = (const bf16_t*)p.out;
    u32x2 qraw[4], hgraw[4];
#pragma unroll
    for (int ib = 0; ib < 4; ++ib) {
        qraw[ib] = *(const u32x2*)(QH + (size_t)(t0 + 16 * ib + fr) * 1024 + 512 + 128 * h + 16 * w + 4 * fq);
        hgraw[ib] = *(const u32x2*)((const bf16_t*)(p.ws + OFF_HG) + (size_t)(t0 + 16 * ib + fr) * 512 + 128 * h + 16 * w + 4 * fq);
    }
    bf16x8 sfa[2][4];
#pragma unroll
    for (int d = 0; d < 2; ++d) { const bf16_t* sp = ST + ((size_t)(cg_ * 4 + h) * 2 + d) * 16384 + (size_t)(16 * w + fr) * 128 + 8 * fq;
#pragma unroll
        for (int ks = 0; ks < 4; ++ks) sfa[d][ks] = *(const bf16x8*)(sp + 32 * ks); }
    if (nxt >= 0) tiles_load(tn, p, nxt, tid);
    f32x4 qv[4];
#pragma unroll
    for (int ib = 0; ib < 4; ++ib) { qv[ib][0] = bflo(qraw[ib][0]); qv[ib][1] = bfhi(qraw[ib][0]); qv[ib][2] = bflo(qraw[ib][1]); qv[ib][3] = bfhi(qraw[ib][1]); }
#pragma unroll
    for (int d = 0; d < 2; ++d) {
        const LAS unsigned char* Gt = d ? Gt1 : Gt0; LAS unsigned char* Qs = QK + d * 2 * 64 * TS; LAS unsigned char* Ks = Qs + 64 * TS;
        f32x4 bT[4]; cumsum_T(Gt, d, w, fr, fq, bT);
        const f32x4 bref = d ? bcast4(bT[2], 16 * fq) : bcast4(bT[1], 16 * fq + 15);
#pragma unroll
        for (int ib = 0; ib < 4; ++ib) {
            const int i = 16 * ib + fr; const int co = (16 * w + 4 * fq) * 2;
            const f32x4 gv = load4bf_lds(Gt + i * TS + co);
            f32x4 a, b;
#pragma unroll
            for (int e = 0; e < 4; ++e) {
                const float kk = 1.0f - __builtin_amdgcn_exp2f(gv[e]); const float db = bT[ib][e] - bref[e];
                a[e] = qv[ib][e] * __builtin_amdgcn_exp2f(db); b[e] = kk * __builtin_amdgcn_exp2f(-db);
            }
            *(LAS u32x2*)(Qs + i * TS + co) = pack4(a); *(LAS u32x2*)(Ks + i * TS + co) = pack4(b);
        }
    }
    __syncthreads();
#pragma unroll
    for (int d = 0; d < 2; ++d) {
        const LAS unsigned char* Qs = QK + d * 2 * 64 * TS; const LAS unsigned char* Ks = Qs + 64 * TS; LAS unsigned char* At = AtB + d * 64 * AS;
        const int ib = w >> 1;
        bf16x8 qf[4];
#pragma unroll
        for (int ks = 0; ks < 4; ++ks) qf[ks] = *(const LAS bf16x8*)(Qs + (16 * ib + fr) * TS + (32 * ks + 8 * fq) * 2);
#pragma unroll
        for (int jj = 0; jj < 2; ++jj) {
            const int jb = 2 * (w & 1) + jj;
            f32x4 a = (f32x4){0.f, 0.f, 0.f, 0.f};
#pragma unroll
            for (int ks = 0; ks < 4; ++ks) { const bf16x8 kf = *(const LAS bf16x8*)(Ks + (16 * jb + fr) * TS + (32 * ks + 8 * fq) * 2); a = mfma16(kf, qf[ks], a); }
            const int i = 16 * ib + fr;
#pragma unroll
            for (int e = 0; e < 4; ++e) { const int j = 16 * jb + 4 * fq + e; const bool on = d ? (j >= i) : (j <= i); a[e] = on ? a[e] : 0.f; }
            *(LAS u32x2*)(At + i * AS + (16 * jb + 4 * fq) * 2) = pack4(a);
        }
    }
    __syncthreads();
    f32x4 o[4];
#pragma unroll
    for (int ib = 0; ib < 4; ++ib) o[ib] = (f32x4){0.f, 0.f, 0.f, 0.f};
    {
        bf16x8 vf[2];
#pragma unroll
        for (int ks = 0; ks < 2; ++ks) vf[ks] = tr_frag(Vt, TS, 32 * ks + 8 * fq, 32 * ks + 8 * fq + 4, 16 * w, fr);
#pragma unroll
        for (int d = 0; d < 2; ++d) {
            const LAS unsigned char* Qs = QK + d * 2 * 64 * TS; const LAS unsigned char* At = AtB + d * 64 * AS;
#pragma unroll
            for (int ib = 0; ib < 4; ++ib) {
#pragma unroll
                for (int ks = 0; ks < 2; ++ks) { const bf16x8 af = *(const LAS bf16x8*)(At + (16 * ib + fr) * AS + (32 * ks + 8 * fq) * 2); o[ib] = mfma16(vf[ks], af, o[ib]); }
#pragma unroll
                for (int ks = 0; ks < 4; ++ks) { const bf16x8 qs = *(const LAS bf16x8*)(Qs + (16 * ib + fr) * TS + (32 * ks + 8 * fq) * 2); o[ib] = mfma16(sfa[d][ks], qs, o[ib]); }
            }
        }
    }
#pragma unroll
    for (int ib = 0; ib < 4; ++ib) {
        float s = o[ib][0] * o[ib][0] + o[ib][1] * o[ib][1] + o[ib][2] * o[ib][2] + o[ib][3] * o[ib][3];
        s += __shfl_xor(s, 16); s += __shfl_xor(s, 32);
        if (fq == 0) red[w * 64 + 16 * ib + fr] = s;
    }
    __syncthreads();
    const f32x4 gw = *(const f32x4*)(p.hgrn_norm_w + 128 * h + 16 * w + 4 * fq);
#pragma unroll
    for (int ib = 0; ib < 4; ++ib) {
        const int i = 16 * ib + fr; float tot = 0.f;
#pragma unroll
        for (int ww = 0; ww < 8; ++ww) tot += red[ww * 64 + i];
        const float rinv = rsqrtf(tot * (1.0f / 128.0f) + EPS);
        f32x4 hg; hg[0] = bflo(hgraw[ib][0]); hg[1] = bfhi(hgraw[ib][0]); hg[2] = bflo(hgraw[ib][1]); hg[3] = bfhi(hgraw[ib][1]);
        *(u32x2*)(obase + (size_t)(t0 + i) * old_ + 128 * h + 16 * w + 4 * fq) = pack4(o[ib] * rinv * gw * hg);
    }
    __syncthreads();
}

__device__ void hgrn_o_pass(LAS unsigned char* lds, const Params& p, int c, int G, bf16_t* obase, int old_) {
    const int tid = threadIdx.x; Tile3 t; int it = c;
    if (it < 3072) tiles_load(t, p, it, tid);
    for (; it < 3072; it += G) {
        tiles_store(lds, t, tid);
        __syncthreads();
        hgrn_o_compute(lds, p, it, obase, old_, t, (it + G < 3072) ? it + G : -1);
    }
}

#define XB_TMO      128
#define XB_XCNT(j)  (256  + 64 * (j))
#define XB_XSUB(j)  (1280 + 64 * (j))
#define XB_XGEN(j)  (2304 + 64 * (j))
#define XB_TOP      3328
#define XB_TOPGEN   3392
#define XCD_BAR_WORDS 3456
#define XB_SPIN_CAP (1u << 18)

__device__ __forceinline__ unsigned xb_ld(unsigned* p)              { return __hip_atomic_load(p, __ATOMIC_RELAXED, __HIP_MEMORY_SCOPE_AGENT); }
__device__ __forceinline__ unsigned xb_add(unsigned* p, unsigned v) { return __hip_atomic_fetch_add(p, v, __ATOMIC_RELAXED, __HIP_MEMORY_SCOPE_AGENT); }
__device__ __forceinline__ unsigned xb_xcc_id() { return (unsigned)__builtin_amdgcn_s_getreg((3 << 11) | 20) & 0xFu; }
#define XB_SPIN(cond, bar) do { unsigned _sp = 0; while (cond) { __builtin_amdgcn_s_sleep(1); \
    if ((++_sp & 255u) == 0u) { if (xb_ld(&(bar)[XB_TMO])) break; if (_sp > XB_SPIN_CAP) { atomicAdd(&(bar)[XB_TMO], 1u); break; } } } } while (0)

struct XcdBarrier {
    unsigned* bar; unsigned x;
    volatile LAS unsigned* st;
};

__device__ __forceinline__ XcdBarrier xcd_barrier_post(unsigned* bar, volatile LAS unsigned* st) {
    XcdBarrier b; b.bar = bar; b.x = xb_xcc_id(); b.st = st;
    if (threadIdx.x == 0) (void)xb_add(&bar[XB_XCNT(b.x)], 1u);
    return b;
}
__device__ __forceinline__ void xcd_barrier_complete(unsigned* bar, unsigned x, unsigned& nloc, unsigned& nx) {
    const unsigned G = gridDim.x * gridDim.y * gridDim.z;
    unsigned sum, cnt, mine, sp = 0u;
    for (;;) {
        sum = 0u; cnt = 0u; mine = 0u;
#pragma unroll
        for (unsigned j = 0; j < 16; ++j) { const unsigned c = xb_ld(&bar[XB_XCNT(j)]); sum += c; cnt += (c > 0u) ? 1u : 0u; mine = (j == x) ? c : mine; }
        if (sum == G) break;
        __builtin_amdgcn_s_sleep(1);
        if ((++sp & 255u) == 0u) { if (xb_ld(&bar[XB_TMO])) break; if (sp > XB_SPIN_CAP) { atomicAdd(&bar[XB_TMO], 1u); break; } }
    }
    nloc = mine > 0u ? mine : 1u; nx = cnt > 0u ? cnt : 1u;
}

__device__ __forceinline__ void xcd_barrier(const XcdBarrier& b) {
    asm volatile("s_waitcnt vmcnt(0)" ::: "memory");
    __syncthreads();
    if (threadIdx.x == 0) {
        unsigned* bar = b.bar;
        __builtin_amdgcn_s_waitcnt(0);
        unsigned nloc = b.st[0], nx = b.st[1];
        if (nloc == 0u) { xcd_barrier_complete(bar, b.x, nloc, nx); b.st[0] = nloc; b.st[1] = nx; }
        const unsigned old = xb_add(&bar[XB_XSUB(b.x)], 1u);
        const unsigned gen = old / nloc;
        if (old + 1u == (gen + 1u) * nloc) {
            __builtin_amdgcn_fence(__ATOMIC_RELEASE, "agent");
            asm volatile("s_waitcnt vmcnt(0)" ::: "memory");
            const unsigned og = xb_add(&bar[XB_TOP], 1u);
            const unsigned tg = og / nx;
            if (og + 1u == (tg + 1u) * nx) xb_add(&bar[XB_TOPGEN], 1u);
            else XB_SPIN(xb_ld(&bar[XB_TOPGEN]) == tg, bar);
            __builtin_amdgcn_fence(__ATOMIC_ACQUIRE, "agent");
            xb_add(&bar[XB_XGEN(b.x)], 1u);
            asm volatile("s_waitcnt vmcnt(0)" ::: "memory");
        } else {
            XB_SPIN(xb_ld(&bar[XB_XGEN(b.x)]) == gen, bar);
            __builtin_amdgcn_fence(__ATOMIC_ACQUIRE, "agent");
            asm volatile("s_waitcnt vmcnt(0)" ::: "memory");
        }
    }
    __syncthreads();
}


#ifdef ONLY_PH
#define PH_ON(k) ((k) == ONLY_PH && p.ph_lo <= (k) && (k) < p.ph_hi)
#else
#define PH_ON(k) (p.ph_lo <= (k) && (k) < p.ph_hi)
#endif
#ifndef DUP_PH
#define DUP_PH -1
#define DUP_N 0
#endif
#define NREP(k) ((DUP_PH == (k)) ? 1 + DUP_N : 1)
#define PH_SYNC(k) if (p.coop && p.ph_lo <= (k) && (k) + 1 < p.ph_hi) { xcd_barrier(xb); }
__global__ void __launch_bounds__(512, 2) fwd_kernel(Params p) {
    extern __shared__ __attribute__((aligned(16))) unsigned char shm_[];
    LAS unsigned char* lds = (LAS unsigned char*)shm_;
#ifdef XCD_CHUNKED
    const int G = gridDim.x, c = (blockIdx.x % (G / 8)) * 8 + blockIdx.x / (G / 8);
#else
    const int G = gridDim.x, c = blockIdx.x;
#endif
    unsigned char* ws = p.ws;
    volatile LAS unsigned* xst = (volatile LAS unsigned*)(lds + XST_OFF);
    if (threadIdx.x == 0) { xst[0] = 0u; xst[1] = 0u; }
    __syncthreads();
    XcdBarrier xb; xb.bar = (unsigned*)(ws + OFF_BAR); xb.x = 0; xb.st = xst;
    if (p.coop) xb = xcd_barrier_post((unsigned*)(ws + OFF_BAR), xst);
    if (p.pad0 == 0x7fffffff) cg::this_grid().sync();
    if (PH_ON(0)) for (int rep = 0; rep < NREP(0); ++rep) { phase_prep(p); if (rep + 1 < NREP(0)) xcd_barrier(xb); }
    PH_SYNC(0)
    if (PH_ON(1)) for (int rep = 0; rep < NREP(1); ++rep) { { pg8::Sched S; S.init(192, 13, G, c, 0); Epi1 E{p}; pg8::gemm_phase(lds, (const bf16_t*)(ws + OFF_H), (const bf16_t*)(ws + OFF_WIN), 1024, S, E); } if (rep + 1 < NREP(1)) xcd_barrier(xb); }
    PH_SYNC(1)
#ifndef DUP_A
#define DUP_A 0
#define DUP_U 0
#define DUP_O 0
#endif
    if (PH_ON(2)) { hgrn_u_pass(lds, p, c, G); }
    PH_SYNC(2)
#ifndef DUP_S
#define DUP_S 0
#endif
    if (PH_ON(3)) {
        for (int it = c; it < 320; it += G) hgrn_scan_item(p, it);
        volatile LAS unsigned* qw = (volatile LAS unsigned*)(lds + XST_OFF + 8);
        unsigned* qhead = (unsigned*)(ws + OFF_BAR + 16384);
        for (;;) {
            if (threadIdx.x == 0) *qw = __hip_atomic_fetch_add(qhead, 1u, __ATOMIC_RELAXED, __HIP_MEMORY_SCOPE_AGENT);
            __syncthreads();
            const unsigned item = *qw;
            if (item >= 768u) break;
            attn_item(lds, p, (int)item, (bf16_t*)(ws + OFF_QH), 1024);
        }
    }
    PH_SYNC(3)
    if (PH_ON(4)) {
        for (int rep = 0; rep <= DUP_O; ++rep) {
            bf16_t* ob = rep < DUP_O ? (bf16_t*)(ws + OFF_BAR + 65536) : (bf16_t*)(ws + OFF_QH) + 512; const int ol = rep < DUP_O ? 512 : 1024;
            hgrn_o_pass(lds, p, c, G, ob, ol);
            if (rep < DUP_O) xcd_barrier(xb);
        }
    }
    PH_SYNC(4)
    if (PH_ON(5)) for (int rep = 0; rep < NREP(5); ++rep) { { pg8::Sched S; S.init(192, 8, G, c, 0); EpiGate E{p}; pg8::gemm_phase(lds, (const bf16_t*)(ws + OFF_H), (const bf16_t*)(ws + OFF_WIN) + (size_t)3328 * 1024, 1024, S, E); } if (rep + 1 < NREP(5)) xcd_barrier(xb); }
    PH_SYNC(5)
#ifdef EXTRA_SYNCS
    for (int q = 0; q < EXTRA_SYNCS; ++q) xcd_barrier(xb);
#endif
    if (PH_ON(6)) {
        { unsigned char* XB = ws + OFF_H; const int gtid = c * 512 + threadIdx.x, gth = G * 512;
          for (int i = gtid; i < (128 + 4 * 192) * 128; i += gth) {
              const int rr = i >> 7, ch = i & 127; int row;
              if (rr < 128) row = rr == 0 ? 0 : 16384 + rr; else { const int q = rr - 128, sq = q / 192, k = q % 192; const int base = 16512 + 8384 * sq; row = k == 0 ? base : base + 8192 + k; }
              *(u32x4*)(XB + (unsigned)(row * 2048 + ch * 16)) = (u32x4){0u, 0u, 0u, 0u};
          } }
        pg8::Sched S; S.init(192, 4, G, c, 0); EpiMix E{p}; pg8::gemm_phase(lds, (const bf16_t*)(ws + OFF_QH), (const bf16_t*)(ws + OFF_WCAT), 1024, S, E); }
    PH_SYNC(6)
    if (PH_ON(7)) { pg8::Sched S; S.init(192, 4, G, c, 0); EpiX1 E{p}; pg8::gemm_phase(lds, (const bf16_t*)(ws + OFF_MIXED), (const bf16_t*)(ws + OFF_WMIX), 1024, S, E); }
    PH_SYNC(7)
    if (PH_ON(8)) for (int rep = 0; rep < NREP(8); ++rep) { { pg8::Sched S; S.init(197, 22, G, c, 1); EpiUp E{p, lds + 131072}; pg8::gemm_phase(lds, (const bf16_t*)(ws + OFF_H), (const bf16_t*)(ws + OFF_WUP), 1024, S, E); } if (rep + 1 < NREP(8)) xcd_barrier(xb); }
    PH_SYNC(8)
    if (PH_ON(9)) { pg8::Sched S; S.init(192, 4, G, c, 0); EpiDown E{p}; pg8::gemm_phase(lds, (const bf16_t*)(ws + OFF_ACT), (const bf16_t*)(ws + OFF_WDN), DFF, S, E); }
    PH_SYNC(9)
    if (PH_ON(10)) {
        const int wv = (c * 512 + threadIdx.x) >> 6, nwv = (G * 512) >> 6, lane = threadIdx.x & 63;
        const float* ss = (const float*)(ws + OFF_SS2); const unsigned char* XB = ws + OFF_H;
        f32x4 wf[2][2];
#pragma unroll
        for (int i = 0; i < 2; ++i) { wf[i][0] = *(const f32x4*)(p.norm_final_w + i * 512 + lane * 8); wf[i][1] = *(const f32x4*)(p.norm_final_w + i * 512 + lane * 8 + 4); }
        for (int r = wv; r < T_TOK; r += nwv) {
            const float rs = rsqrtf(ss[r] * (1.0f / 1024.0f) + EPS);
            const unsigned pr = (unsigned)(r + padoff_of(r));
#pragma unroll
            for (int i = 0; i < 2; ++i) {
                f32x4 a, b; load8((const bf16_t*)(XB + (unsigned)(pr * 2048 + (i * 512 + lane * 8) * 2)), a, b);
                float* o = p.out + (size_t)r * 1024 + i * 512 + lane * 8;
                __builtin_nontemporal_store(a * rs * wf[i][0], (f32x4*)o); __builtin_nontemporal_store(b * rs * wf[i][1], (f32x4*)(o + 4));
            }
        } }
}

#ifdef DBG_NANCHK
__global__ void dbg_init(unsigned* flag) { if (threadIdx.x == 0 && blockIdx.x == 0) { flag[0] = 99u; flag[1] = 0u; } }
__global__ void dbg_chk(const void* buf, size_t n, int is_f32, unsigned id, unsigned* flag) {
    bool bad = false;
    for (size_t i = (size_t)blockIdx.x * blockDim.x + threadIdx.x; i < n; i += (size_t)gridDim.x * blockDim.x) {
        float v = is_f32 ? ((const float*)buf)[i] : bf2f(((const bf16_t*)buf)[i]);
        if (!(fabsf(v) < 1e30f)) bad = true;
    }
    if (bad) atomicMin(flag, id);
}
__global__ void dbg_cnt(const void* buf, size_t n, unsigned* cnt) {
    unsigned c = 0;
    for (size_t i = (size_t)blockIdx.x * blockDim.x + threadIdx.x; i < n; i += (size_t)gridDim.x * blockDim.x) {
        float v = bf2f(((const bf16_t*)buf)[i]);
        if (!(fabsf(v) < 1e30f)) ++c;
    }
    if (c) atomicAdd(cnt, c);
}
__global__ void dbg_fin(float* out, const unsigned* flag) { if (threadIdx.x == 0 && blockIdx.x == 0) { unsigned f = flag[1]; out[0] = 100.0f * log2f(1.0f + (float)f); } }
#define CHK(ptr, n, f32, id) hipLaunchKernelGGL(dbg_chk, dim3(1024), dim3(256), 0, stream, (const void*)(ptr), (size_t)(n), f32, id, flag)
#endif
#ifdef DBG_UCHK
__global__ void dbg_ucheck(const unsigned char* ws, const float* outp, int cg_, int h, int dir, float* res) {
    const bf16_t* G = (const bf16_t*)(ws + (dir ? OFF_GB : OFF_GF)); const bf16_t* V = (const bf16_t*)(ws + OFF_HI);
    const bf16_t* ST = (const bf16_t*)outp;
    const int e = blockIdx.x * blockDim.x + threadIdx.x; if (e >= 16384) return;
    const int dv = e >> 7, dk = e & 127; const int t0 = cg_ * 64;
    float tot = 0.f; for (int t = 0; t < 64; ++t) tot += bf2f(G[(size_t)(t0 + t) * 512 + 128 * h + dk]);
    float u = 0.f, run = 0.f;
    for (int tt = 0; tt < 64; ++tt) { const int t = dir ? 63 - tt : tt; const float g = bf2f(G[(size_t)(t0 + t) * 512 + 128 * h + dk]); run += g;
        const float kd = (1.0f - expf(g)) * expf(tot - run); u += kd * bf2f(V[(size_t)(t0 + t) * 512 + 128 * h + dv]); }
    const float got = bf2f(ST[((size_t)(cg_ * 4 + h) * 2 + dir) * 16384 + dv * 128 + dk]);
    float d = fabsf(got - u); if (!(d < 1e30f)) d = 1e3f;
    atomicMax((unsigned*)res, __float_as_uint(d)); atomicMax((unsigned*)res + 1, __float_as_uint(fabsf(u)));
}
__global__ void dbg_stats(const unsigned char* ws, unsigned* fl) {
    const bf16_t* GF = (const bf16_t*)(ws + OFF_GF); const bf16_t* HI = (const bf16_t*)(ws + OFF_HI);
    unsigned f = 0;
    for (size_t i = (size_t)blockIdx.x * blockDim.x + threadIdx.x; i < (size_t)T_TOK * 1024; i += (size_t)gridDim.x * blockDim.x) {
        const float g = bf2f(GF[i]); if (g > 1e-3f) f |= 1u; if (g < -50.f) f |= 2u; }
    for (size_t i = (size_t)blockIdx.x * blockDim.x + threadIdx.x; i < (size_t)T_TOK * 512; i += (size_t)gridDim.x * blockDim.x) {
        const float v = bf2f(HI[i]); if (fabsf(v) > 100.f) f |= 4u; }
    if (f) atomicOr(fl, f);
}
__global__ void dbg_ufin(float* out, const float* res) { if (threadIdx.x == 0 && blockIdx.x == 0) { unsigned f = ((const unsigned*)res)[2]; if (!(res[1] < 1e30f)) f |= 8u; out[0] = 100.0f * (float)(1u + f); } }
#endif
extern "C" void kernel_launch(void* const* d_in, const int* in_sizes, int n_in, void* d_out, int out_size, void* d_ws, size_t ws_size, hipStream_t stream) {
    static int grid_blocks = 0;
    if (!grid_blocks) {
        hipFuncSetAttribute((const void*)fwd_kernel, hipFuncAttributeMaxDynamicSharedMemorySize, LDS_BYTES);
        int dev = 0, cus = 0, per_cu = 0;
        hipGetDevice(&dev);
        hipDeviceGetAttribute(&cus, hipDeviceAttributeMultiprocessorCount, dev);
        hipOccupancyMaxActiveBlocksPerMultiprocessor(&per_cu, fwd_kernel, 512, LDS_BYTES);
        if (per_cu < 1) per_cu = 1;
        grid_blocks = cus * 1;
    }
    Params p{};
    p.x_prompt = (const float*)d_in[0]; p.x_sample = (const float*)d_in[1]; p.norm_mix_w = (const float*)d_in[2]; p.w_in = (const float*)d_in[3];
    p.attn_sink = (const float*)d_in[4]; p.lb_logits = (const float*)d_in[5]; p.hgrn_norm_w = (const float*)d_in[6]; p.w_attn_out = (const float*)d_in[7];
    p.w_hgrn_out = (const float*)d_in[8]; p.w_mix_out = (const float*)d_in[9]; p.norm_ffn_w = (const float*)d_in[10]; p.w_up = (const float*)d_in[11];
    p.conv_w = (const float*)d_in[12]; p.conv_b = (const float*)d_in[13]; p.w_down = (const float*)d_in[14]; p.norm_final_w = (const float*)d_in[15];
    p.out = (float*)d_out; p.ws = (unsigned char*)d_ws; p.pad0 = 0;
    if (ws_size < WS_END + ((size_t)64 << 20)) { fprintf(stderr, "workspace too small: %zu < %zu\n", ws_size, (size_t)WS_END); return; }
#if MEGA
    p.ph_lo = 0; p.ph_hi = 11; p.coop = 1;
    (void)hipMemsetAsync((unsigned char*)d_ws + OFF_BAR, 0, 16384 + 1024, stream);
    void* args[] = {&p};
    hipError_t e = hipLaunchCooperativeKernel((const void*)fwd_kernel, dim3(grid_blocks), dim3(512), args, LDS_BYTES, stream);
    if (e != hipSuccess) fprintf(stderr, "cooperative launch failed: %s (grid %d)\n", hipGetErrorString(e), grid_blocks);
#else
#ifdef DBG_NANCHK
    unsigned* flag = (unsigned*)((unsigned char*)d_ws + WS_END + 256);
    unsigned char* w = (unsigned char*)d_ws;
    hipLaunchKernelGGL(dbg_init, dim3(1), dim3(64), 0, stream, flag);
#endif
    for (int ph = 0; ph < 11; ++ph) {
        p.ph_lo = ph; p.ph_hi = ph + 1; p.coop = 0;
#ifdef DBG_NANCHK
        if (ph == 2) hipMemsetAsync(d_out, 0, (size_t)T_TOK * 4096, stream);
#endif
        hipLaunchKernelGGL(fwd_kernel, dim3(grid_blocks), dim3(512), LDS_BYTES, stream, p);
#ifdef DBG_UCHK
        if (ph == 2) { float* res = (float*)((unsigned char*)d_ws + WS_END + 512); hipMemsetAsync(res, 0, 16, stream); hipLaunchKernelGGL(dbg_stats, dim3(1024), dim3(256), 0, stream, (const unsigned char*)d_ws, (unsigned*)res + 2);
            for (int dd = 0; dd < 2; ++dd) { hipLaunchKernelGGL(dbg_ucheck, dim3(64), dim3(256), 0, stream, (const unsigned char*)d_ws, (const float*)d_out, 5, 1, dd, res);
                                             hipLaunchKernelGGL(dbg_ucheck, dim3(64), dim3(256), 0, stream, (const unsigned char*)d_ws, (const float*)d_out, 700, 3, dd, res); } }
#endif
#ifdef DBG_NANCHK
        const size_t T = T_TOK;
        if (ph == 0) { CHK(w + OFF_WIN, (size_t)DIN * 1024, 0, 1u); CHK(w + OFF_WCAT, 1024 * 1024, 0, 2u); CHK(w + OFF_WMIX, 1024 * 1024, 0, 3u); CHK(w + OFF_WUP, 5632 * 1024, 0, 4u);
                       CHK(w + OFF_WDN, 1024 * DFF, 0, 5u); CHK(w + OFF_ROTC, 2 * 16384 * 32, 1, 6u); CHK(w + OFF_H, T * 1024, 0, 7u); }
        if (ph == 1) { CHK(w + OFF_QH, T * 1024, 0, 8u); CHK(w + OFF_K, T * 128, 0, 9u); CHK(w + OFF_V, T * 128, 0, 10u); CHK(w + OFF_GF, T * 512, 0, 11u); CHK(w + OFF_GB, T * 512, 0, 12u);
                       CHK(w + OFF_HI, T * 512, 0, 13u); CHK(w + OFF_HG, T * 512, 0, 14u); }
        if (ph == 2) { hipLaunchKernelGGL(dbg_cnt, dim3(1024), dim3(256), 0, stream, (const void*)d_out, (size_t)T * 2048, flag + 1); CHK(w + OFF_QH, T * 1024, 0, 15u); CHK(d_out, T * 2048, 0, 16u); CHK(w + OFF_DC, (size_t)NCHUNK * 8 * 128, 1, 17u); }
        if (ph == 3) { CHK(d_out, T * 2048, 0, 18u); }
        if (ph == 4) { CHK(w + OFF_QH, T * 1024, 0, 19u); }
        if (ph == 5) { CHK(d_out, T * 2048, 0, 20u); }
        if (ph == 6) { CHK(w + OFF_MIXED, T * 1024, 0, 21u); }
        if (ph == 7) { CHK(d_out, T * 1024, 1, 22u); CHK(w + OFF_SS1, T, 1, 23u); CHK(w + OFF_H, (size_t)PADROWS * 1024, 0, 24u); }
        if (ph == 8) { CHK(w + OFF_ACT, T * DFF, 0, 25u); }
        if (ph == 9) { CHK(d_out, T * 1024, 1, 26u); CHK(w + OFF_SS2, T, 1, 27u); }
#endif
    }
#ifdef DBG_UCHK
    hipLaunchKernelGGL(dbg_ufin, dim3(1), dim3(64), 0, stream, (float*)d_out, (const float*)((unsigned char*)d_ws + WS_END + 512));
#endif
#ifdef DBG_NANCHK
    hipLaunchKernelGGL(dbg_fin, dim3(1), dim3(64), 0, stream, (float*)d_out, flag);
#endif
#endif
}
```

```cpp
#include <hip/hip_runtime.h>
#include <hip/hip_cooperative_groups.h>
#include <cstdio>
namespace cg = cooperative_groups;

#ifndef MEGA
#define MEGA 1
#endif

#define LAS __attribute__((address_space(3)))
typedef unsigned short bf16_t;
typedef short bf16x8 __attribute__((ext_vector_type(8)));
typedef short s16x4 __attribute__((ext_vector_type(4)));
typedef float f32x4 __attribute__((ext_vector_type(4)));
typedef unsigned u32x4 __attribute__((ext_vector_type(4)));
typedef unsigned u32x2 __attribute__((ext_vector_type(2)));

constexpr int T_TOK = 49152, DM = 1024, DIN = 5376, DFF = 2816;
constexpr int NCHUNK = 768;
constexpr int PADROWS = 16512 + 4 * 8384;
constexpr float EPS = 1e-6f;

constexpr size_t OFF_WIN = 0;
constexpr size_t OFF_WCAT = OFF_WIN + (size_t)DIN * 1024 * 2;
constexpr size_t OFF_WMIX = OFF_WCAT + (size_t)1024 * 1024 * 2;
constexpr size_t OFF_WUP = OFF_WMIX + (size_t)1024 * 1024 * 2;
constexpr size_t OFF_WDN = OFF_WUP + (size_t)5632 * 1024 * 2;
constexpr size_t OFF_ROTC = OFF_WDN + (size_t)1024 * DFF * 2;
constexpr size_t OFF_ROTS = OFF_ROTC + (size_t)16384 * 32 * 4;
constexpr size_t OFF_SS1 = OFF_ROTS + (size_t)16384 * 32 * 4;
constexpr size_t OFF_SS2 = OFF_SS1 + (size_t)T_TOK * 4;
constexpr size_t OFF_DC = OFF_SS2 + (size_t)T_TOK * 4;
constexpr size_t OFF_H = OFF_DC + (size_t)NCHUNK * 4 * 2 * 128 * 4;
constexpr size_t OFF_QH = OFF_H + (size_t)PADROWS * 1024 * 2;
constexpr size_t OFF_K = OFF_QH + (size_t)T_TOK * 1024 * 2;
constexpr size_t OFF_V = OFF_K + (size_t)T_TOK * 128 * 2;
constexpr size_t OFF_GF = OFF_V + (size_t)T_TOK * 128 * 2;
constexpr size_t OFF_GB = OFF_GF + (size_t)T_TOK * 512 * 2;
constexpr size_t OFF_HI = OFF_GB + (size_t)T_TOK * 512 * 2;
constexpr size_t OFF_HG = OFF_HI + (size_t)T_TOK * 512 * 2;
constexpr size_t WS_END = OFF_HG + (size_t)T_TOK * 512 * 2;
constexpr size_t OFF_ACT = OFF_QH;
constexpr size_t OFF_MIXED = OFF_GF;

constexpr int XST_OFF = 140288;
constexpr int LDS_BYTES = XST_OFF + 16;
constexpr size_t OFF_EREF_REL = (size_t)60 << 20;
constexpr size_t OFF_BAR = WS_END;

struct Params {
    const float* x_prompt; const float* x_sample; const float* norm_mix_w; const float* w_in; const float* attn_sink;
    const float* lb_logits; const float* hgrn_norm_w; const float* w_attn_out; const float* w_hgrn_out; const float* w_mix_out;
    const float* norm_ffn_w; const float* w_up; const float* conv_w; const float* conv_b; const float* w_down; const float* norm_final_w;
    float* out; unsigned char* ws;
    int ph_lo, ph_hi, coop, pad0;
};

typedef __bf16 bf2_t __attribute__((ext_vector_type(2)));
typedef float f32x2_t __attribute__((ext_vector_type(2)));
__device__ __forceinline__ unsigned pk_bf16(float lo, float hi) { f32x2_t v = {lo, hi}; bf2_t r = __builtin_convertvector(v, bf2_t); return __builtin_bit_cast(unsigned, r); }
__device__ __forceinline__ float bf2f(unsigned short b) { return __uint_as_float(((unsigned)b) << 16); }
__device__ __forceinline__ float bflo(unsigned u) { return __uint_as_float(u << 16); }
__device__ __forceinline__ float bfhi(unsigned u) { return __uint_as_float(u & 0xffff0000u); }
__device__ __forceinline__ void store8(bf16_t* dst, f32x4 a, f32x4 b) {
    u32x4 v; v[0] = pk_bf16(a[0], a[1]); v[1] = pk_bf16(a[2], a[3]); v[2] = pk_bf16(b[0], b[1]); v[3] = pk_bf16(b[2], b[3]);
    *(u32x4*)dst = v;
}
__device__ __forceinline__ void load8(const bf16_t* src, f32x4& a, f32x4& b) {
    u32x4 v = *(const u32x4*)src;
    a[0] = bflo(v[0]); a[1] = bfhi(v[0]); a[2] = bflo(v[1]); a[3] = bfhi(v[1]);
    b[0] = bflo(v[2]); b[1] = bfhi(v[2]); b[2] = bflo(v[3]); b[3] = bfhi(v[3]);
}
__device__ __forceinline__ f32x4 load4bf(const bf16_t* src) { u32x2 v = *(const u32x2*)src; f32x4 a; a[0] = bflo(v[0]); a[1] = bfhi(v[0]); a[2] = bflo(v[1]); a[3] = bfhi(v[1]); return a; }
__device__ __forceinline__ f32x4 load4bf_lds(const LAS unsigned char* src) { u32x2 v = *(const LAS u32x2*)src; f32x4 a; a[0] = bflo(v[0]); a[1] = bfhi(v[0]); a[2] = bflo(v[1]); a[3] = bfhi(v[1]); return a; }
__device__ __forceinline__ u32x2 pack4(f32x4 a) { u32x2 v; v[0] = pk_bf16(a[0], a[1]); v[1] = pk_bf16(a[2], a[3]); return v; }
__device__ __forceinline__ float sigmoidf_(float z) { return __builtin_amdgcn_rcpf(1.0f + __builtin_amdgcn_exp2f(z * -1.4426950408889634f)); }
__device__ __forceinline__ f32x4 mfma16(bf16x8 a, bf16x8 b, f32x4 c) { return __builtin_amdgcn_mfma_f32_16x16x32_bf16(a, b, c, 0, 0, 0); }
__device__ __forceinline__ bf16x8 tr_frag(const LAS unsigned char* tile, int stride, int rowA, int rowB, int c0, int fr) {
    const LAS unsigned char* pa = tile + (rowA + (fr >> 2)) * stride + (c0 + 4 * (fr & 3)) * 2;
    const LAS unsigned char* pb = tile + (rowB + (fr >> 2)) * stride + (c0 + 4 * (fr & 3)) * 2;
    s16x4 lo = __builtin_amdgcn_ds_read_tr16_b64_v4i16((LAS s16x4*)pa);
    s16x4 hi = __builtin_amdgcn_ds_read_tr16_b64_v4i16((LAS s16x4*)pb);
    bf16x8 r; r[0] = lo[0]; r[1] = lo[1]; r[2] = lo[2]; r[3] = lo[3]; r[4] = hi[0]; r[5] = hi[1]; r[6] = hi[2]; r[7] = hi[3];
    return r;
}
__device__ __forceinline__ void seq_of(int t, int& start, int& len) {
    if (t < 16384) { start = 0; len = 16384; } else { start = 16384 + ((t - 16384) & ~8191); len = 8192; }
}
__device__ __forceinline__ const float* xrow(const Params& p, int r) { return r < 16384 ? p.x_prompt + (size_t)r * 1024 : p.x_sample + (size_t)(r - 16384) * 1024; }
__device__ __forceinline__ int padoff_of(int r) { return r < 16384 ? 1 : 129 + 192 * ((r - 16384) >> 13); }

namespace pg8 {
constexpr int BM = 256, BK = 64, HALF = 128, HTB = HALF * BK * 2, NXCD = 8, WGM = 8;
__host__ __device__ __forceinline__ int lds_byte(int r, int c) { const int st = (r >> 4) * 2 + (c >> 5), rr = r & 15, cc = c & 31, ob = rr * 64 + cc * 2; return st * 1024 + (ob ^ (((ob >> 9) & 1) << 5)); }
__host__ __device__ __forceinline__ void stage_rc(int b, int& R, int& C) { const int st = b / 1024, sb = b % 1024, swz = sb ^ (((sb >> 9) & 1) << 5); R = (st >> 1) * 16 + swz / 64; C = (st & 1) * 32 + (swz % 64) / 2; }
__host__ __device__ __forceinline__ int perm32(int rho) { const int n = rho >> 4, i = rho & 15; return 8 * (i >> 2) + 4 * n + (i & 3); }
struct Unit { int pm, pn; };
struct Sched {
    int nM, nN, nwg, G, c, mode;
    __device__ void init(int nM_, int nN_, int G_, int c_, int mode_) { nM = nM_; nN = nN_; nwg = nM * nN; G = G_; c = c_; mode = mode_; }
    __device__ bool next(int i, Unit& u) const {
        const long L = (long)i * G + c; if (L >= nwg) return false;
        int wgid = (int)L; { const int q = nwg / NXCD, r = nwg % NXCD, xcd = wgid % NXCD, off = wgid / NXCD; wgid = (xcd < r ? xcd * (q + 1) : r * (q + 1) + (xcd - r) * q) + off; }
        const int nig = WGM * nN, gid = wgid / nig, fm = gid * WGM, gsz = (nM - fm) < WGM ? (nM - fm) : WGM;
        u.pm = fm + ((wgid % nig) % gsz); u.pn = (wgid % nig) / gsz; return true;
    }
    __device__ __forceinline__ long arow(int pm) const {
        if (mode == 0) return (long)pm * 256;
        if (pm < 65) return (long)pm * 254;
        const int q = pm - 65; return 16512 + (long)(q / 33) * 8384 + (long)(q % 33) * 254;
    }
};

template <class Epi>
__device__ __forceinline__ void gemm_phase(LAS unsigned char* lds, const bf16_t* Ag, const bf16_t* Btg, const int K, const Sched& S, Epi& E) {
    const int tid = threadIdx.x, wid = __builtin_amdgcn_readfirstlane(tid >> 6), lane = tid & 63, wr = wid >> 2, wc = wid & 3, fr = lane & 15, fq = lane >> 4;
    const int nt = K / BK;
    unsigned voffA[2], voffB[2];
#pragma unroll
    for (int i = 0; i < 2; ++i) { int R, C; stage_rc(tid * 16 + i * 8192, R, C); const int Rb = Epi::PERM ? ((R & ~31) + perm32(R & 31)) : R;
        voffA[i] = (unsigned)(R * K + C) * 2u; voffB[i] = (unsigned)(Rb * K + C) * 2u; }
    const size_t kstep = (size_t)(BK * 2);
    const size_t hstep = (size_t)HALF * K * 2;
    const size_t tstep = 2 * hstep;
    const size_t rowb = (size_t)K * 2;
    const unsigned ldsw = (unsigned)wid * 1024u;
    const int aoff = lds_byte(wr * 64 + fr, fq * 8), boff = lds_byte(wc * 32 + fr, fq * 8);
#define PG8_SA(b, h) (((b) * 2 + (h)) * HTB)
#define PG8_SB(b, h) ((4 + (b) * 2 + (h)) * HTB)
#define PG8_STAGE(bufoff, gbase, voff) do { _Pragma("unroll") for (int _i = 0; _i < 2; ++_i) \
        __builtin_amdgcn_global_load_lds((const unsigned*)((const char*)(gbase) + (voff)[_i]), (LAS unsigned*)(lds + (bufoff) + ldsw + _i * 8192), 16, 0, 0); } while (0)
#define PG8_LDA(dst, b, h) do { _Pragma("unroll") for (int m = 0; m < 4; ++m) _Pragma("unroll") for (int k = 0; k < 2; ++k) dst[m][k] = *(const LAS bf16x8*)(lds + PG8_SA(b, h) + aoff + m * 2048 + k * 1024); } while (0)
#define PG8_LDB(dst, b, h) do { _Pragma("unroll") for (int n = 0; n < 2; ++n) _Pragma("unroll") for (int k = 0; k < 2; ++k) dst[n][k] = *(const LAS bf16x8*)(lds + PG8_SB(b, h) + boff + n * 2048 + k * 1024); } while (0)
#define PG8_MMA(ai, bj, At, Bt) do { __builtin_amdgcn_s_setprio(1); _Pragma("unroll") for (int m = 0; m < 4; ++m) _Pragma("unroll") for (int n = 0; n < 2; ++n) _Pragma("unroll") for (int k = 0; k < 2; ++k) \
        acc[ai][bj][m][n] = __builtin_amdgcn_mfma_f32_16x16x32_bf16(Bt[n][k], At[m][k], acc[ai][bj][m][n], 0, 0, 0); __builtin_amdgcn_s_setprio(0); } while (0)
#define PG8_WAIT_V(n) asm volatile("s_waitcnt vmcnt(" #n ")" ::: "memory")
#define PG8_WAIT_L(n) asm volatile("s_waitcnt lgkmcnt(" #n ")" ::: "memory")
#define PG8_BAR __builtin_amdgcn_s_barrier()
#define PG8_SCHED __builtin_amdgcn_sched_barrier(0)
    Unit cur, nxt; int ui = 0;
    if (!S.next(0, cur)) return;
    f32x4 acc[2][2][4][2];
#pragma unroll
    for (int a = 0; a < 2; ++a)
#pragma unroll
        for (int b = 0; b < 2; ++b)
#pragma unroll
            for (int m = 0; m < 4; ++m)
#pragma unroll
                for (int n = 0; n < 2; ++n) acc[a][b][m][n] = (f32x4){0.f, 0.f, 0.f, 0.f};
    bf16x8 At[4][2], B0[2][2], B1[2][2];
    const char* cA = (const char*)Ag + (size_t)S.arow(cur.pm) * rowb; const char* cB = (const char*)Btg + (size_t)cur.pn * tstep;
    PG8_STAGE(PG8_SB(0, 0), cB, voffB); PG8_STAGE(PG8_SA(0, 0), cA, voffA); PG8_STAGE(PG8_SB(0, 1), cB + hstep, voffB); PG8_STAGE(PG8_SA(0, 1), cA + hstep, voffA);
    if (wr == 1) PG8_BAR;
    PG8_WAIT_V(4); PG8_BAR;
    PG8_STAGE(PG8_SB(1, 0), cB + kstep, voffB); PG8_STAGE(PG8_SA(1, 0), cA + kstep, voffA); PG8_STAGE(PG8_SB(1, 1), cB + hstep + kstep, voffB);
    PG8_WAIT_V(6); PG8_BAR;
    for (;;) {
        const bool has_next = S.next(ui + 1, nxt);
        const char* nA = has_next ? (const char*)Ag + (size_t)S.arow(nxt.pm) * rowb : cA; const char* nB = has_next ? (const char*)Btg + (size_t)nxt.pn * tstep : cB;
        for (int t = 0; t < nt; t += 2) {
            const bool last = (t == nt - 2);
            const char* a1 = cA + (size_t)(t + 1) * kstep;
            const char* a2 = last ? nA : cA + (size_t)(t + 2) * kstep; const char* b2 = last ? nB : cB + (size_t)(t + 2) * kstep;
            const char* a3 = a2 + kstep; const char* b3 = b2 + kstep;
            if constexpr (Epi::MIDK) { if (t == (nt >> 1)) E.mid(acc, cur, wr, wc, fr, fq); }
            PG8_LDB(B0, 0, 0); PG8_SCHED; PG8_LDA(At, 0, 0); PG8_STAGE(PG8_SA(1, 1), a1 + hstep, voffA);
            PG8_WAIT_L(8); PG8_BAR; PG8_WAIT_L(0); PG8_MMA(0, 0, At, B0); PG8_BAR; PG8_SCHED;
            PG8_LDB(B1, 0, 1); PG8_STAGE(PG8_SB(0, 0), b2, voffB);
            PG8_BAR; PG8_WAIT_L(0); PG8_MMA(0, 1, At, B1); PG8_BAR;
            PG8_LDA(At, 0, 1); PG8_STAGE(PG8_SA(0, 0), a2, voffA);
            PG8_BAR; PG8_WAIT_L(0); PG8_MMA(1, 0, At, B0); PG8_BAR; PG8_SCHED;
            PG8_STAGE(PG8_SB(0, 1), b2 + hstep, voffB);
            PG8_WAIT_V(6); PG8_BAR; PG8_MMA(1, 1, At, B1); PG8_BAR;
            PG8_LDB(B0, 1, 0); PG8_SCHED; PG8_LDA(At, 1, 0); PG8_STAGE(PG8_SA(0, 1), a2 + hstep, voffA);
            PG8_WAIT_L(8); PG8_BAR; PG8_WAIT_L(0); PG8_MMA(0, 0, At, B0); PG8_BAR; PG8_SCHED;
            PG8_LDB(B1, 1, 1); PG8_STAGE(PG8_SB(1, 0), b3, voffB);
            PG8_BAR; PG8_WAIT_L(0); PG8_MMA(0, 1, At, B1); PG8_BAR;
            PG8_LDA(At, 1, 1); PG8_STAGE(PG8_SA(1, 0), a3, voffA);
            PG8_BAR; PG8_WAIT_L(0); PG8_MMA(1, 0, At, B0); PG8_BAR; PG8_SCHED;
            PG8_STAGE(PG8_SB(1, 1), b3 + hstep, voffB);
            PG8_WAIT_V(6); PG8_BAR; PG8_MMA(1, 1, At, B1); PG8_BAR;
        }
        E(acc, cur, wr, wc, fr, fq);
        if (!has_next) break;
#pragma unroll
        for (int a = 0; a < 2; ++a)
#pragma unroll
            for (int b = 0; b < 2; ++b)
#pragma unroll
                for (int m = 0; m < 4; ++m)
#pragma unroll
                    for (int n = 0; n < 2; ++n) acc[a][b][m][n] = (f32x4){0.f, 0.f, 0.f, 0.f};
        cur = nxt; cA = nA; cB = nB; ++ui;
    }
    PG8_WAIT_V(0);
    if (wr == 0) PG8_BAR;
    PG8_BAR;
#undef PG8_SA
#undef PG8_SB
#undef PG8_STAGE
#undef PG8_LDA
#undef PG8_LDB
#undef PG8_MMA
#undef PG8_WAIT_V
#undef PG8_WAIT_L
#undef PG8_BAR
#undef PG8_SCHED
}
}
using pg8::Unit;
typedef f32x4 AccT[2][2][4][2];

__device__ __forceinline__ unsigned opq0() { unsigned z; asm volatile("v_mov_b32 %0, 0" : "=v"(z)); return z; }
struct Epi1 {
    static constexpr bool PERM = true, MIDK = false;
    Params p;
    __device__ __forceinline__ void operator()(const AccT& acc, const Unit& u, int wr, int wc, int fr, int fq) const {
        const int pn = u.pn; const unsigned row0 = u.pm * 256 + wr * 64 + fr + opq0();
        if (pn <= 2) {
            int start, len; seq_of(u.pm * 256, start, len);
            const unsigned char* rotc = p.ws + OFF_ROTC; const unsigned char* rots = p.ws + OFF_ROTS;
            const unsigned dl = 16 * (wc & 1) + 4 * fq;
            unsigned char* b0; unsigned char* b1; unsigned ld, c0, c1;
            if (pn < 2) { b0 = p.ws + OFF_QH; b1 = b0; ld = 2048; c0 = (256 * pn + 32 * wc + 8 * fq) * 2; c1 = c0 + 256; }
            else { b0 = p.ws + OFF_K; b1 = p.ws + OFF_V; ld = 256; c0 = (32 * wc + 8 * fq) * 2; c1 = c0; }
#pragma unroll
            for (int ai = 0; ai < 2; ++ai) {
                f32x4 csv[4], snv[4];
#pragma unroll
                for (int m = 0; m < 4; ++m) { const unsigned pos = row0 + ai * 128 + m * 16 - start;
                    csv[m] = *(const f32x4*)(rotc + (unsigned)((pos * 32 + dl) * 4)); snv[m] = *(const f32x4*)(rots + (unsigned)((pos * 32 + dl) * 4)); }
#pragma unroll
                for (int m = 0; m < 4; ++m) {
                    const unsigned r = row0 + ai * 128 + m * 16;
                    const f32x4 cs = csv[m], sn = snv[m];
                    { const f32x4 v0 = acc[ai][0][m][0], v1 = acc[ai][0][m][1];
                      store8((bf16_t*)(b0 + (unsigned)(r * ld + c0)), v0 * cs - v1 * sn, v1 * cs + v0 * sn); }
                    { const f32x4 v0 = acc[ai][1][m][0], v1 = acc[ai][1][m][1];
                      if (pn == 2) store8((bf16_t*)(b1 + (unsigned)(r * ld + c1)), v0, v1);
                      else store8((bf16_t*)(b1 + (unsigned)(r * ld + c1)), v0 * cs - v1 * sn, v1 * cs + v0 * sn); }
                }
                asm volatile("" ::: "memory");
            }
        } else if (pn <= 4 || (pn >= 9 && pn <= 12)) {
            unsigned char* base; unsigned ld, cb;
            if (pn <= 4) { base = p.ws + OFF_QH; ld = 2048; cb = 512 + 256 * (pn - 3); }
            else if (pn <= 10) { base = p.ws + OFF_HI; ld = 1024; cb = 256 * (pn - 9); }
            else { base = p.ws + OFF_HG; ld = 1024; cb = 256 * (pn - 11); }
            const bool act = pn >= 11;
            const unsigned c0 = (cb + 32 * wc + 8 * fq) * 2;
#pragma unroll
            for (int ai = 0; ai < 2; ++ai)
#pragma unroll
                for (int m = 0; m < 4; ++m) {
                    const unsigned r = row0 + ai * 128 + m * 16;
#pragma unroll
                    for (int bj = 0; bj < 2; ++bj) {
                        f32x4 v0 = acc[ai][bj][m][0], v1 = acc[ai][bj][m][1];
                        if (act) {
#pragma unroll
                            for (int e = 0; e < 4; ++e) { v0[e] = v0[e] * sigmoidf_(v0[e]); v1[e] = v1[e] * sigmoidf_(v1[e]); }
                        }
                        store8((bf16_t*)(base + (unsigned)(r * ld + c0 + 256 * bj)), v0, v1);
                    }
                    asm volatile("" ::: "memory");
                }
        } else {
            const int dir = (pn - 5) >> 1; const unsigned cb = 256 * ((pn - 5) & 1);
            unsigned char* base = p.ws + (dir ? OFF_GB : OFF_GF);
#pragma unroll
            for (int bj = 0; bj < 2; ++bj) {
                const unsigned col = cb + 128 * bj + 32 * wc + 8 * fq;
                float lb[8];
#pragma unroll
                for (int e = 0; e < 8; ++e) { const float l0 = p.lb_logits[dir * 512 + col + e], l1 = p.lb_logits[1024 + dir * 512 + col + e]; lb[e] = __builtin_amdgcn_rcpf(1.0f + __expf(l1 - l0)); }
#pragma unroll
                for (int ai = 0; ai < 2; ++ai)
#pragma unroll
                    for (int m = 0; m < 4; ++m) {
                        const unsigned r = row0 + ai * 128 + m * 16;
                        f32x4 v0 = acc[ai][bj][m][0], v1 = acc[ai][bj][m][1];
#pragma unroll
                        for (int e = 0; e < 4; ++e) {
                            v0[e] = __builtin_amdgcn_logf(lb[e] + (1.0f - lb[e]) * sigmoidf_(v0[e]));
                            v1[e] = __builtin_amdgcn_logf(lb[4 + e] + (1.0f - lb[4 + e]) * sigmoidf_(v1[e]));
                        }
                        store8((bf16_t*)(base + (unsigned)((r * 512 + col) * 2)), v0, v1);
                        asm volatile("" ::: "memory");
                    }
            }
        }
    }
};
struct EpiGate {
    static constexpr bool PERM = true, MIDK = false;
    Params p;
    __device__ __forceinline__ void operator()(const AccT& acc, const Unit& u, int wr, int wc, int fr, int fq) const {
        unsigned char* G = (unsigned char*)p.out; const unsigned row0 = u.pm * 256 + wr * 64 + fr + opq0();
        const unsigned c0 = (128 * u.pn + 32 * wc + 8 * fq) * 2;
#pragma unroll
        for (int ai = 0; ai < 2; ++ai)
#pragma unroll
            for (int m = 0; m < 4; ++m) {
                const unsigned r = row0 + ai * 128 + m * 16;
                f32x4 rt[2], sh[2];
#pragma unroll
                for (int n = 0; n < 2; ++n)
#pragma unroll
                    for (int e = 0; e < 4; ++e) {
                        const float ea = __builtin_amdgcn_exp2f(acc[ai][0][m][n][e] * -1.4426950408889634f), eh = __builtin_amdgcn_exp2f(acc[ai][1][m][n][e] * -1.4426950408889634f);
                        const float sga = __builtin_amdgcn_rcpf(1.0f + ea);
                        sh[n][e] = __builtin_amdgcn_rcpf(1.0f + eh); rt[n][e] = sga * (1.0f + eh);
                    }
                store8((bf16_t*)(G + (unsigned)(r * 4096 + c0)), rt[0], rt[1]);
                store8((bf16_t*)(G + (unsigned)(r * 4096 + 2048 + c0)), sh[0], sh[1]);
                asm volatile("" ::: "memory");
            }
    }
};
struct EpiMix {
    static constexpr bool PERM = true, MIDK = true;
    Params p;
    template <int OFFB> __device__ __forceinline__ void scale(AccT& acc, const Unit& u, int wr, int wc, int fr, int fq) const {
        const unsigned char* G = (const unsigned char*)p.out; const unsigned row0 = u.pm * 256 + wr * 64 + fr + opq0();
        const unsigned c0 = (256 * u.pn + 32 * wc + 8 * fq) * 2 + OFFB;
#pragma unroll
        for (int ai = 0; ai < 2; ++ai) {
            u32x4 g[4][2];
#pragma unroll
            for (int m = 0; m < 4; ++m)
#pragma unroll
                for (int bj = 0; bj < 2; ++bj) g[m][bj] = *(const u32x4*)(G + (unsigned)((row0 + ai * 128 + m * 16) * 4096 + c0 + 256 * bj));
#pragma unroll
            for (int m = 0; m < 4; ++m)
#pragma unroll
                for (int bj = 0; bj < 2; ++bj) {
                    const u32x4 v = g[m][bj];
                    acc[ai][bj][m][0][0] *= bflo(v[0]); acc[ai][bj][m][0][1] *= bfhi(v[0]); acc[ai][bj][m][0][2] *= bflo(v[1]); acc[ai][bj][m][0][3] *= bfhi(v[1]);
                    acc[ai][bj][m][1][0] *= bflo(v[2]); acc[ai][bj][m][1][1] *= bfhi(v[2]); acc[ai][bj][m][1][2] *= bflo(v[3]); acc[ai][bj][m][1][3] *= bfhi(v[3]);
                }
            asm volatile("" ::: "memory");
        }
    }
    __device__ __forceinline__ void mid(AccT& acc, const Unit& u, int wr, int wc, int fr, int fq) const { scale<0>(acc, u, wr, wc, fr, fq); }
    __device__ __forceinline__ void operator()(AccT& acc, const Unit& u, int wr, int wc, int fr, int fq) const {
        scale<2048>(acc, u, wr, wc, fr, fq);
        unsigned char* MX = p.ws + OFF_MIXED; const unsigned row0 = u.pm * 256 + wr * 64 + fr + opq0();
        const unsigned c0 = (256 * u.pn + 32 * wc + 8 * fq) * 2;
#pragma unroll
        for (int ai = 0; ai < 2; ++ai)
#pragma unroll
            for (int m = 0; m < 4; ++m)
#pragma unroll
                for (int bj = 0; bj < 2; ++bj)
                    store8((bf16_t*)(MX + (unsigned)((row0 + ai * 128 + m * 16) * 2048 + c0 + 256 * bj)), acc[ai][bj][m][0], acc[ai][bj][m][1]);
    }
};
struct EpiX1 {
    static constexpr bool PERM = true, MIDK = false;
    Params p;
    __device__ __forceinline__ void operator()(const AccT& acc, const Unit& u, int wr, int wc, int fr, int fq) const {
        const unsigned row0 = u.pm * 256 + wr * 64 + fr + opq0(); const unsigned po = padoff_of(u.pm * 256);
        unsigned char* XB = p.ws + OFF_H; float* ss = (float*)(p.ws + OFF_SS1);
        const bool pr = u.pm < 64; const unsigned char* xb = (const unsigned char*)(pr ? p.x_prompt : p.x_sample); const unsigned xr0 = pr ? 0u : 16384u;
        const unsigned c0 = 256 * u.pn + 32 * wc + 8 * fq;
#pragma unroll
        for (int ai = 0; ai < 2; ++ai) {
            f32x4 xv[4][2][2];
#pragma unroll
            for (int m = 0; m < 4; ++m)
#pragma unroll
                for (int bj = 0; bj < 2; ++bj) { const unsigned char* xp = xb + (unsigned)(((row0 + ai * 128 + m * 16 - xr0) * 1024 + c0 + 128 * bj) * 4);
                    xv[m][bj][0] = *(const f32x4*)xp; xv[m][bj][1] = *(const f32x4*)(xp + 16); }
#pragma unroll
            for (int m = 0; m < 4; ++m) {
                const unsigned r = row0 + ai * 128 + m * 16; float s = 0.f;
#pragma unroll
                for (int bj = 0; bj < 2; ++bj) {
                    const unsigned c = c0 + 128 * bj;
                    const f32x4 v0 = acc[ai][bj][m][0] + xv[m][bj][0], v1 = acc[ai][bj][m][1] + xv[m][bj][1];
                    store8((bf16_t*)(XB + (unsigned)(((r + po) * 1024 + c) * 2)), v0, v1);
#pragma unroll
                    for (int e = 0; e < 4; ++e) s += v0[e] * v0[e] + v1[e] * v1[e];
                }
                s += __shfl_xor(s, 16); s += __shfl_xor(s, 32);
                if (fq == 0) atomicAdd(ss + r, s);
            }
            asm volatile("" ::: "memory");
        }
    }
};
struct EpiDown {
    static constexpr bool PERM = true, MIDK = false;
    Params p;
    __device__ __forceinline__ void operator()(const AccT& acc, const Unit& u, int wr, int wc, int fr, int fq) const {
        const unsigned row0 = u.pm * 256 + wr * 64 + fr + opq0(); float* ss = (float*)(p.ws + OFF_SS2); unsigned char* XB = p.ws + OFF_H;
        const unsigned po = padoff_of(u.pm * 256);
        const unsigned c0 = (256 * u.pn + 32 * wc + 8 * fq) * 2;
#pragma unroll
        for (int ai = 0; ai < 2; ++ai) {
            u32x4 xv[4][2];
#pragma unroll
            for (int m = 0; m < 4; ++m)
#pragma unroll
                for (int bj = 0; bj < 2; ++bj) xv[m][bj] = *(const u32x4*)(XB + (unsigned)((row0 + ai * 128 + m * 16 + po) * 2048 + c0 + 256 * bj));
#pragma unroll
            for (int m = 0; m < 4; ++m) {
                const unsigned r = row0 + ai * 128 + m * 16; float s = 0.f;
#pragma unroll
                for (int bj = 0; bj < 2; ++bj) {
                    const u32x4 x = xv[m][bj];
                    f32x4 v0 = acc[ai][bj][m][0], v1 = acc[ai][bj][m][1];
                    v0[0] += bflo(x[0]); v0[1] += bfhi(x[0]); v0[2] += bflo(x[1]); v0[3] += bfhi(x[1]);
                    v1[0] += bflo(x[2]); v1[1] += bfhi(x[2]); v1[2] += bflo(x[3]); v1[3] += bfhi(x[3]);
                    store8((bf16_t*)(XB + (unsigned)((r + po) * 2048 + c0 + 256 * bj)), v0, v1);
#pragma unroll
                    for (int e = 0; e < 4; ++e) s += v0[e] * v0[e] + v1[e] * v1[e];
                }
                s += __shfl_xor(s, 16); s += __shfl_xor(s, 32);
                if (fq == 0) atomicAdd(ss + r, s);
            }
            asm volatile("" ::: "memory");
        }
    }
};
__device__ __forceinline__ float dpp_ror1(float v) { return __int_as_float(__builtin_amdgcn_mov_dpp(__float_as_int(v), 0x121, 0xf, 0xf, true)); }
__device__ __forceinline__ float dpp_ror15(float v) { return __int_as_float(__builtin_amdgcn_mov_dpp(__float_as_int(v), 0x12F, 0xf, 0xf, true)); }
struct EpiUp {
    static constexpr bool PERM = true, MIDK = false;
    Params p; LAS unsigned char* exch;
    __device__ __forceinline__ void operator()(AccT& acc, const Unit& u, int wr, int wc, int fr, int fq) const {
        int seq, ti; if (u.pm < 65) { seq = 0; ti = u.pm; } else { const int q = u.pm - 65; seq = 1 + q / 33; ti = q % 33; }
        const int start = seq == 0 ? 0 : 16384 + 8192 * (seq - 1), len = seq == 0 ? 16384 : 8192;
        const unsigned char* ss = p.ws + OFF_SS1;
        unsigned char* ACT = p.ws + OFF_ACT;
        LAS float* ex = (LAS float*)exch;
        const int R0 = 64 * wr + fr + (int)opq0(); const int pos0 = 254 * ti + R0 - 1;
        const unsigned char* cwp = (const unsigned char*)p.conv_w; const unsigned char* cbp = (const unsigned char*)p.conv_b;
        const unsigned jb = 128 * u.pn + 32 * wc + 8 * fq + opq0();
        f32x4 cwv[2][4];
#pragma unroll
        for (int bj = 0; bj < 2; ++bj) { const unsigned col = bj * DFF + jb;
            cwv[bj][0] = *(const f32x4*)(cwp + (unsigned)(col * 4)); cwv[bj][1] = *(const f32x4*)(cwp + (unsigned)((5632 + col) * 4));
            cwv[bj][2] = *(const f32x4*)(cwp + (unsigned)((2 * 5632 + col) * 4)); cwv[bj][3] = *(const f32x4*)(cbp + (unsigned)(col * 4)); }
#pragma unroll
        for (int ai = 0; ai < 2; ++ai)
#pragma unroll
            for (int m = 0; m < 4; ++m) {
                const int pos = pos0 + 128 * ai + 16 * m;
                float rs = 0.f; if (pos >= 0 && pos < len) rs = rsqrtf(*(const float*)(ss + (unsigned)((start + pos) * 4)) * (1.0f / 1024.0f) + EPS);
#pragma unroll
                for (int bj = 0; bj < 2; ++bj)
#pragma unroll
                    for (int n = 0; n < 2; ++n) acc[ai][bj][m][n] *= rs;
            }
        const int clb = 32 * wc + 8 * fq + (int)opq0();
        const bool fr0 = (fr == 0), fr15 = (fr == 15);
#pragma unroll
        for (int ai = 0; ai < 2; ++ai) {
            const int seg = 2 * ai + wr;
#pragma unroll
            for (int bj = 0; bj < 2; ++bj)
#pragma unroll
                for (int n = 0; n < 2; ++n) {
                    const int cl = 128 * bj + clb + 4 * n;
                    if (fr == 0) *(LAS f32x4*)(ex + (seg * 2 + 0) * 256 + cl) = acc[ai][bj][0][n];
                    if (fr == 15) *(LAS f32x4*)(ex + (seg * 2 + 1) * 256 + cl) = acc[ai][bj][3][n];
                }
        }
        asm volatile("s_waitcnt lgkmcnt(0)" ::: "memory");
        __builtin_amdgcn_s_barrier(); __builtin_amdgcn_s_barrier();
        asm volatile("" ::: "memory");
#pragma unroll
        for (int n = 0; n < 2; ++n) {
            const unsigned jc = 128 * u.pn + clb + 4 * n;
            if (n == 1) {
#pragma unroll
                for (int bj = 0; bj < 2; ++bj) { const unsigned col = bj * DFF + jb + 4;
                    cwv[bj][0] = *(const f32x4*)(cwp + (unsigned)(col * 4)); cwv[bj][1] = *(const f32x4*)(cwp + (unsigned)((5632 + col) * 4));
                    cwv[bj][2] = *(const f32x4*)(cwp + (unsigned)((2 * 5632 + col) * 4)); cwv[bj][3] = *(const f32x4*)(cbp + (unsigned)(col * 4)); }
            }
#pragma unroll
            for (int ai = 0; ai < 2; ++ai) {
                const int seg = 2 * ai + wr;
                f32x4 val[4];
#pragma unroll
                for (int bj = 0; bj < 2; ++bj) {
                    const f32x4 cw0 = cwv[bj][0], cw1 = cwv[bj][1], cw2 = cwv[bj][2], cbv = cwv[bj][3];
                    const int cl = 128 * bj + clb + 4 * n;
                    f32x4 prevlast = (f32x4){0.f, 0.f, 0.f, 0.f}, nextfirst = (f32x4){0.f, 0.f, 0.f, 0.f};
                    if (seg > 0) prevlast = *(LAS f32x4*)(ex + ((seg - 1) * 2 + 1) * 256 + cl);
                    if (seg < 3) nextfirst = *(LAS f32x4*)(ex + ((seg + 1) * 2 + 0) * 256 + cl);
#pragma unroll
                    for (int m = 0; m < 4; ++m) {
                        const f32x4 cur = acc[ai][bj][m][n];
                        const f32x4 pv = m > 0 ? acc[ai][bj][m > 0 ? m - 1 : 0][n] : prevlast;
                        const f32x4 nx = m < 3 ? acc[ai][bj][m < 3 ? m + 1 : 3][n] : nextfirst;
                        f32x4 su, sd, up, dn;
#pragma unroll
                        for (int e = 0; e < 4; ++e) { su[e] = fr15 ? pv[e] : cur[e]; sd[e] = fr0 ? nx[e] : cur[e]; }
#pragma unroll
                        for (int e = 0; e < 4; ++e) up[e] = dpp_ror1(su[e]);
#pragma unroll
                        for (int e = 0; e < 4; ++e) dn[e] = dpp_ror15(sd[e]);
                        const f32x4 res = cw0 * up + cw1 * cur + cw2 * dn + cbv;
                        if (bj == 0) val[m] = res;
                        else {
                            const int R = 128 * ai + 16 * m + R0; const int pos = pos0 + 128 * ai + 16 * m;
                            f32x4 o;
#pragma unroll
                            for (int e = 0; e < 4; ++e) { const float g = res[e]; o[e] = g * sigmoidf_(g) * val[m][e]; }
                            const bool ok = (R >= 1) && (R <= 254) && (pos < len);
                            const unsigned off = ok ? (unsigned)(((start + pos) * DFF + jc) * 2) : (unsigned)(OFF_BAR + 20480 - OFF_ACT) + threadIdx.x * 8u;
                            *(u32x2*)(ACT + off) = pack4(o);
                        }
                        __builtin_amdgcn_sched_barrier(0);
                    }
                    asm volatile("" ::: "memory");
                }
            }
        }
    }
};

template <class ColMap>
__device__ __forceinline__ void conv_weight(bf16_t* dst, int Nd, int K, const ColMap& cm, int gtid, int gthreads) {
    const int kc_n = K / 8; const long total = (long)Nd * kc_n;
    for (long ci = gtid; ci < total; ci += gthreads) {
        const int kc = (int)(ci / Nd), n = (int)(ci % Nd);
        float v[8];
#pragma unroll
        for (int e = 0; e < 8; ++e) v[e] = cm(n, kc * 8 + e);
        u32x4 o; o[0] = pk_bf16(v[0], v[1]); o[1] = pk_bf16(v[2], v[3]); o[2] = pk_bf16(v[4], v[5]); o[3] = pk_bf16(v[6], v[7]);
        *(u32x4*)(dst + (size_t)n * K + kc * 8) = o;
    }
}
__device__ void phase_prep(const Params& p) {
    const int gtid = blockIdx.x * blockDim.x + threadIdx.x, gthreads = gridDim.x * blockDim.x;
    unsigned char* ws = p.ws;
    {
        const float* w = p.w_in; const float* nw = p.norm_mix_w;
        auto cm = [=](int n, int k) -> float {
            int col = n; float sc = nw[k];
            if (n < 640) { const int hd = n >> 6, q = n & 63; const int d = 16 * (q >> 5) + 4 * ((q & 31) >> 3) + (q & 3) + 32 * ((q & 7) >> 2); col = 64 * hd + d; if (n < 512) sc *= 0.125f * 1.4426950408889634f; }
            else if (n >= 3328) { const int t = n - 3328, tile = t >> 8, r = t & 255; col = r < 128 ? 3328 + 128 * tile + r : 4352 + 128 * tile + (r - 128); }
            return w[(size_t)k * DIN + col] * sc; };
        conv_weight((bf16_t*)(ws + OFF_WIN), DIN, 1024, cm, gtid, gthreads);
    }
    {   const float* wa = p.w_attn_out; const float* wh = p.w_hgrn_out;
        auto cm = [=](int n, int k) -> float { return k < 512 ? wa[(size_t)k * 1024 + n] : wh[(size_t)(k - 512) * 1024 + n]; };
        conv_weight((bf16_t*)(ws + OFF_WCAT), 1024, 1024, cm, gtid, gthreads); }
    {   const float* w = p.w_mix_out;
        auto cm = [=](int n, int k) -> float { return w[(size_t)k * 1024 + n]; };
        conv_weight((bf16_t*)(ws + OFF_WMIX), 1024, 1024, cm, gtid, gthreads); }
    {   const float* w = p.w_up; const float* nw = p.norm_ffn_w;
        auto cm = [=](int n, int k) -> float { const int tile = n >> 8, r = n & 255; const int col = r < 128 ? 128 * tile + r : DFF + 128 * tile + (r - 128); return w[(size_t)k * 5632 + col] * nw[k]; };
        conv_weight((bf16_t*)(ws + OFF_WUP), 5632, 1024, cm, gtid, gthreads); }
    {   const float* w = p.w_down;
        auto cm = [=](int n, int k) -> float { return w[(size_t)k * 1024 + n]; };
        conv_weight((bf16_t*)(ws + OFF_WDN), 1024, DFF, cm, gtid, gthreads); }
    {   float* rc = (float*)(ws + OFF_ROTC); float* rsn = (float*)(ws + OFF_ROTS);
        for (int i = gtid; i < 16384 * 32; i += gthreads) {
            const int pos = i >> 5, k = i & 31;
            const double f = exp(-(double)k * (9.210340371976184 / 32.0));
            const double ang = (double)pos * f;
            const double kk = rint(ang * 0.15915494309189535);
            double r = fma(-kk, 6.283185307179586, ang); r = fma(-kk, 2.4492935982947064e-16, r);
            const float rf = (float)r;
            rc[i] = __cosf(rf); rsn[i] = __sinf(rf);
        } }
    {   float* s1 = (float*)(ws + OFF_SS1);
        for (int i = gtid; i < 2 * T_TOK; i += gthreads) s1[i] = 0.f; }
    {   const int wv = gtid >> 6, nwv = gthreads >> 6, lane = threadIdx.x & 63;
        bf16_t* H = (bf16_t*)(ws + OFF_H);
        for (int r = 2 * wv; r < T_TOK; r += 2 * nwv) {
            f32x4 v[2][4]; float s[2] = {0.f, 0.f};
#pragma unroll
            for (int q = 0; q < 2; ++q) { const float* xr = xrow(p, r + q);
#pragma unroll
                for (int i = 0; i < 4; ++i) v[q][i] = __builtin_nontemporal_load((const f32x4*)(xr + i * 256 + lane * 4)); }
#pragma unroll
            for (int q = 0; q < 2; ++q) {
#pragma unroll
                for (int i = 0; i < 4; ++i)
#pragma unroll
                    for (int e = 0; e < 4; ++e) s[q] += v[q][i][e] * v[q][i][e];
#pragma unroll
                for (int o = 32; o >= 1; o >>= 1) s[q] += __shfl_xor(s[q], o);
                const float rs = rsqrtf(s[q] * (1.0f / 1024.0f) + EPS);
#pragma unroll
                for (int i = 0; i < 4; ++i) *(u32x2*)(H + (size_t)(r + q) * 1024 + i * 256 + lane * 4) = pack4(v[q][i] * rs);
            }
        } }
}

__device__ void attn_item(LAS unsigned char* lds, const Params& p, int item, bf16_t* obase, int old_) {
    const int tid = threadIdx.x, wid = tid >> 6, lane = tid & 63, fr = lane & 15, fq = lane >> 4;
    const int g = item & 1, blk = item >> 1, t0 = blk * 128;
    int start, len; seq_of(t0, start, len);
    constexpr int KS = 144, NROW = 400;
    LAS unsigned char* Kt = lds; LAS unsigned char* Vt = lds + NROW * KS;
    const bf16_t* Kg = (const bf16_t*)(p.ws + OFF_K); const bf16_t* Vg = (const bf16_t*)(p.ws + OFF_V);
    bf16_t* QH = (bf16_t*)(p.ws + OFF_QH);
    for (int c = tid; c < NROW * 8; c += 512) {
        const int row = c >> 3, ch = c & 7; const int tk = t0 - 128 + row;
        u32x4 kv = (u32x4){0u, 0u, 0u, 0u}, vv = (u32x4){0u, 0u, 0u, 0u};
        if (row < 384 && tk >= start && tk < start + len) { kv = *(const u32x4*)(Kg + (size_t)tk * 128 + 64 * g + 8 * ch); vv = *(const u32x4*)(Vg + (size_t)tk * 128 + 64 * g + 8 * ch); }
        *(LAS u32x4*)(Kt + row * KS + ch * 16) = kv; *(LAS u32x4*)(Vt + row * KS + ch * 16) = vv;
    }
    __syncthreads();
    const int hh = wid >> 1, half = wid & 1, head = 4 * g + hh;
    const float sink2 = p.attn_sink[head] * 1.4426950408889634f;
    for (int qg = 0; qg < 4; ++qg) {
        const int tq0 = 64 * half + 16 * qg, nb0 = tq0 >> 4;
        const bf16_t* qp = QH + (size_t)(t0 + tq0 + fr) * 1024 + 64 * head + 8 * fq;
        const bf16x8 qf0 = *(const bf16x8*)qp, qf1 = *(const bf16x8*)(qp + 32);
        f32x4 st[18];
        const bool firstb = (t0 == start), lastb = (t0 + 128 == start + len);
#pragma unroll
        for (int nbr = 0; nbr < 17; ++nbr) {
            const LAS unsigned char* kr = Kt + (16 * (nb0 + nbr) + fr) * KS + 16 * fq;
            const bf16x8 k0 = *(const LAS bf16x8*)kr, k1 = *(const LAS bf16x8*)(kr + 64);
            f32x4 a = (f32x4){0.f, 0.f, 0.f, 0.f};
            a = mfma16(k0, qf0, a); a = mfma16(k1, qf1, a);
            st[nbr] = a;
        }
        float mx = sink2;
#pragma unroll
        for (int nbr = 0; nbr < 17; ++nbr) {
            const int nb = nb0 + nbr;
            if ((firstb && nb < 8) || (lastb && nb >= 16)) st[nbr] = (f32x4){-INFINITY, -INFINITY, -INFINITY, -INFINITY};
            if (nbr == 0) {
#pragma unroll
                for (int j = 0; j < 4; ++j) st[nbr][j] = (4 * fq + j >= fr) ? st[nbr][j] : -INFINITY;
            }
            if (nbr == 16) {
#pragma unroll
                for (int j = 0; j < 4; ++j) st[nbr][j] = (4 * fq + j <= fr) ? st[nbr][j] : -INFINITY;
            }
#pragma unroll
            for (int j = 0; j < 4; ++j) mx = fmaxf(mx, st[nbr][j]);
        }
        mx = fmaxf(mx, __shfl_xor(mx, 16)); mx = fmaxf(mx, __shfl_xor(mx, 32));
        float l = 0.f;
#pragma unroll
        for (int nbr = 0; nbr < 17; ++nbr)
#pragma unroll
            for (int j = 0; j < 4; ++j) { const float e = __builtin_amdgcn_exp2f(st[nbr][j] - mx); st[nbr][j] = e; l += e; }
        st[17] = (f32x4){0.f, 0.f, 0.f, 0.f};
        l += __shfl_xor(l, 16); l += __shfl_xor(l, 32); l += __builtin_amdgcn_exp2f(sink2 - mx);
        const float inv = 1.0f / l;
        f32x4 ot[4];
#pragma unroll
        for (int db = 0; db < 4; ++db) ot[db] = (f32x4){0.f, 0.f, 0.f, 0.f};
#pragma unroll
        for (int i = 0; i < 9; ++i) {
            bf16x8 pf; { const unsigned a0 = pk_bf16(st[2 * i][0], st[2 * i][1]), a1 = pk_bf16(st[2 * i][2], st[2 * i][3]), b0 = pk_bf16(st[2 * i + 1][0], st[2 * i + 1][1]), b1 = pk_bf16(st[2 * i + 1][2], st[2 * i + 1][3]);
                u32x4 t; t[0] = a0; t[1] = a1; t[2] = b0; t[3] = b1; pf = __builtin_bit_cast(bf16x8, t); }
            const int rowA = 16 * (nb0 + 2 * i) + 4 * fq;
#pragma unroll
            for (int db = 0; db < 4; ++db) {
                const bf16x8 vf = tr_frag(Vt, KS, rowA, rowA + 16, 16 * db, fr);
                ot[db] = mfma16(vf, pf, ot[db]);
            }
        }
        bf16_t* op = obase + (size_t)(t0 + tq0 + fr) * old_ + 64 * head + 4 * fq;
#pragma unroll
        for (int db = 0; db < 4; ++db) *(u32x2*)(op + 16 * db) = pack4(ot[db] * inv);
    }
    __syncthreads();
}

constexpr int TS = 272;
__device__ __forceinline__ void stage_tile64(LAS unsigned char* dst, const bf16_t* src, int ld, int tid) {
#pragma unroll
    for (int i = 0; i < 2; ++i) { const int c = tid + i * 512; const int row = c >> 4, ch = c & 15;
        *(LAS u32x4*)(dst + row * TS + ch * 16) = *(const u32x4*)(src + (size_t)row * ld + ch * 8); }
}
__device__ __forceinline__ void cumsum_T(const LAS unsigned char* Gt, int dir, int w, int fr, int fq, f32x4 (&bT)[4]) {
    bf16x8 gfrag[2];
#pragma unroll
    for (int ks = 0; ks < 2; ++ks) gfrag[ks] = tr_frag(Gt, TS, 32 * ks + 8 * fq, 32 * ks + 8 * fq + 4, 16 * w, fr);
#pragma unroll
    for (int ib = 0; ib < 4; ++ib) {
        f32x4 a = (f32x4){0.f, 0.f, 0.f, 0.f};
#pragma unroll
        for (int ks = 0; ks < 2; ++ks) {
            bf16x8 L; const int i = 16 * ib + fr;
#pragma unroll
            for (int e = 0; e < 8; ++e) { const int j = 32 * ks + 8 * fq + e; const bool on = dir ? (j >= i) : (j <= i); L[e] = on ? (short)0x3F80 : (short)0; }
            a = mfma16(gfrag[ks], L, a);
        }
        bT[ib] = a;
    }
}
__device__ __forceinline__ f32x4 bcast4(const f32x4& v, int srclane) { f32x4 r;
#pragma unroll
    for (int e = 0; e < 4; ++e) r[e] = __shfl(v[e], srclane); return r; }
__device__ __forceinline__ f32x4 exp4(f32x4 a) { f32x4 r;
#pragma unroll
    for (int e = 0; e < 4; ++e) r[e] = __builtin_amdgcn_exp2f(a[e]); return r; }

struct Tile3 { u32x4 r[6]; };
__device__ __forceinline__ void tiles_load(Tile3& t, const Params& p, int item, int tid) {
    const int h = item & 3, t0 = (item >> 2) * 64;
    const unsigned char* src[3] = { p.ws + OFF_GF, p.ws + OFF_GB, p.ws + OFF_HI };
#pragma unroll
    for (int k = 0; k < 3; ++k)
#pragma unroll
        for (int i = 0; i < 2; ++i) { const int c = tid + i * 512; const int row = c >> 4, ch = c & 15;
            t.r[2 * k + i] = *(const u32x4*)(src[k] + (unsigned)(((t0 + row) * 512 + 128 * h + ch * 8) * 2)); }
}
__device__ __forceinline__ void tiles_store(LAS unsigned char* lds, const Tile3& t, int tid) {
#pragma unroll
    for (int k = 0; k < 3; ++k)
#pragma unroll
        for (int i = 0; i < 2; ++i) { const int c = tid + i * 512; const int row = c >> 4, ch = c & 15;
            *(LAS u32x4*)(lds + k * 64 * TS + row * TS + ch * 16) = t.r[2 * k + i]; }
}
__device__ __forceinline__ void hgrn_u_compute(LAS unsigned char* lds, const Params& p, int item) {
    const int tid = threadIdx.x, w = tid >> 6, lane = tid & 63, fr = lane & 15, fq = lane >> 4;
    const int h = item & 3, cg_ = item >> 2;
    LAS unsigned char* Gt0 = lds; LAS unsigned char* Gt1 = lds + 64 * TS; LAS unsigned char* Vt = lds + 2 * 64 * TS; LAS unsigned char* Kd0 = lds + 3 * 64 * TS;
    bf16_t* ST = (bf16_t*)p.out; float* DC = (float*)(p.ws + OFF_DC);
#pragma unroll
    for (int dir = 0; dir < 2; ++dir) {
        const LAS unsigned char* Gt = dir ? Gt1 : Gt0; LAS unsigned char* Kd = Kd0 + dir * 64 * TS;
        f32x4 bT[4]; cumsum_T(Gt, dir, w, fr, fq, bT);
        const f32x4 blast = dir ? bcast4(bT[0], 16 * fq) : bcast4(bT[3], 16 * fq + 15);
        const f32x4 bref = dir ? bcast4(bT[2], 16 * fq) : bcast4(bT[1], 16 * fq + 15);
        if (fr == 0) { const f32x4 dcv = exp4(blast), erv = exp4(bref);
                       u32x4 rec; rec[0] = pk_bf16(dcv[0], dcv[1]); rec[1] = pk_bf16(dcv[2], dcv[3]); rec[2] = pk_bf16(erv[0], erv[1]); rec[3] = pk_bf16(erv[2], erv[3]);
                       *(u32x4*)((unsigned char*)DC + ((size_t)(cg_ * 4 + h) * 2 + dir) * 512 + (4 * w + fq) * 16) = rec; }
#pragma unroll
        for (int ib = 0; ib < 4; ++ib) {
            const int i = 16 * ib + fr;
            const f32x4 gv = load4bf_lds(Gt + i * TS + (16 * w + 4 * fq) * 2);
            f32x4 kd;
#pragma unroll
            for (int e = 0; e < 4; ++e) kd[e] = (1.0f - __builtin_amdgcn_exp2f(gv[e])) * __builtin_amdgcn_exp2f(blast[e] - bT[ib][e]);
            *(LAS u32x2*)(Kd + i * TS + (16 * w + 4 * fq) * 2) = pack4(kd);
        }
    }
    asm volatile("s_waitcnt lgkmcnt(0)" ::: "memory");
    bf16x8 kf[2][2];
#pragma unroll
    for (int dir = 0; dir < 2; ++dir)
#pragma unroll
        for (int ks = 0; ks < 2; ++ks) kf[dir][ks] = tr_frag(Kd0 + dir * 64 * TS, TS, 32 * ks + 8 * fq, 32 * ks + 8 * fq + 4, 16 * w, fr);
    bf16_t* dst = ST + ((size_t)(cg_ * 4 + h) * 2) * 16384;
#pragma unroll
    for (int jb = 0; jb < 8; ++jb) {
        f32x4 a0 = (f32x4){0.f, 0.f, 0.f, 0.f}, a1 = (f32x4){0.f, 0.f, 0.f, 0.f};
#pragma unroll
        for (int ks = 0; ks < 2; ++ks) { const bf16x8 vf = tr_frag(Vt, TS, 32 * ks + 8 * fq, 32 * ks + 8 * fq + 4, 16 * jb, fr); a0 = mfma16(kf[0][ks], vf, a0); a1 = mfma16(kf[1][ks], vf, a1); }
        bf16_t* q = dst + (size_t)(16 * jb + fr) * 128 + 16 * w + 4 * fq;
        *(u32x2*)q = pack4(a0); *(u32x2*)(q + 16384) = pack4(a1);
    }
}

__device__ void hgrn_u_pass(LAS unsigned char* lds, const Params& p, int c, int G) {
    const int tid = threadIdx.x; Tile3 t; int it = c;
    if (it < 3072) tiles_load(t, p, it, tid);
    for (; it < 3072; it += G) {
        tiles_store(lds, t, tid);
        __syncthreads();
        if (it + G < 3072) tiles_load(t, p, it + G, tid);
        hgrn_u_compute(lds, p, it);
        __syncthreads();
    }
}

__device__ void hgrn_scan_item(const Params& p, int item) {
    int chain, slice; if (item < 64) { chain = item >> 3; slice = item & 7; } else { chain = 8 + ((item - 64) >> 3); slice = item & 7; }
    int seq, hd; if (chain < 8) { seq = 0; hd = chain; } else { seq = 1 + ((chain - 8) >> 3); hd = (chain - 8) & 7; }
    const int h = hd >> 1, dir = hd & 1;
    const int c0 = seq == 0 ? 0 : 256 + 128 * (seq - 1), n = seq == 0 ? 256 : 128;
    const int e4 = slice * 512 + threadIdx.x;
    const int dk4 = (e4 & 31) * 4;
    bf16_t* ST = (bf16_t*)p.out; const float* DC = (const float*)(p.ws + OFF_DC);
    f32x4 s = (f32x4){0.f, 0.f, 0.f, 0.f};
    u32x2 uu[2][8]; u32x4 de[2][8];
#define SCAN_LOAD(B, CC) do { _Pragma("unroll") for (int k = 0; k < 8; ++k) { \
        const int c = dir ? (c0 + n - 1 - ((CC) + k)) : (c0 + (CC) + k); const size_t slot = ((size_t)(c * 4 + h) * 2 + dir); \
        uu[B][k] = *(const u32x2*)(ST + slot * 16384 + (size_t)e4 * 4); \
        de[B][k] = *(const u32x4*)((const unsigned char*)DC + slot * 512 + (size_t)(e4 & 31) * 16); } } while (0)
#define SCAN_STEP(B, CC) do { _Pragma("unroll") for (int k = 0; k < 8; ++k) { \
        const int c = dir ? (c0 + n - 1 - ((CC) + k)) : (c0 + (CC) + k); const size_t slot = ((size_t)(c * 4 + h) * 2 + dir); \
        f32x4 dd, er; dd[0] = bflo(de[B][k][0]); dd[1] = bfhi(de[B][k][0]); dd[2] = bflo(de[B][k][1]); dd[3] = bfhi(de[B][k][1]); \
        er[0] = bflo(de[B][k][2]); er[1] = bfhi(de[B][k][2]); er[2] = bflo(de[B][k][3]); er[3] = bfhi(de[B][k][3]); \
        *(u32x2*)(ST + slot * 16384 + (size_t)e4 * 4) = pack4(s * er);     \
        f32x4 u; u[0] = bflo(uu[B][k][0]); u[1] = bfhi(uu[B][k][0]); u[2] = bflo(uu[B][k][1]); u[3] = bfhi(uu[B][k][1]); \
        s = dd * s + u; } } while (0)
    SCAN_LOAD(0, 0);
    for (int cc = 0; cc < n; cc += 16) {
        SCAN_LOAD(1, cc + 8);
        SCAN_STEP(0, cc);
        if (cc + 16 < n) SCAN_LOAD(0, cc + 16);
        SCAN_STEP(1, cc + 8);
    }
#undef SCAN_LOAD
#undef SCAN_STEP
}

__device__ __forceinline__ void hgrn_o_compute(LAS unsigned char* lds, const Params& p, int item, bf16_t* obase, int old_, Tile3& tn, int nxt) {
    const int tid = threadIdx.x, w = tid >> 6, lane = tid & 63, fr = lane & 15, fq = lane >> 4;
    const int h = item & 3, cg_ = item >> 2, t0 = cg_ * 64;
    LAS unsigned char* Gt0 = lds; LAS unsigned char* Gt1 = lds + 64 * TS; LAS unsigned char* Vt = lds + 2 * 64 * TS;
    LAS unsigned char* QK = lds + 3 * 64 * TS;
    constexpr int AS = 144;
    LAS unsigned char* AtB = lds + 7 * 64 * TS;
    LAS float* red = (LAS float*)lds;
    bf16_t* QH = (bf16_t*)(p.ws + OFF_QH);
    const bf16_t* ST = (const bf16_t*)p.out;
    u32x2 qraw[4], hgraw[4];
#pragma unroll
    for (int ib = 0; ib < 4; ++ib) {
        qraw[ib] = *(const u32x2*)(QH + (size_t)(t0 + 16 * ib + fr) * 1024 + 512 + 128 * h + 16 * w + 4 * fq);
        hgraw[ib] = *(const u32x2*)((const bf16_t*)(p.ws + OFF_HG) + (size_t)(t0 + 16 * ib + fr) * 512 + 128 * h + 16 * w + 4 * fq);
    }
    bf16x8 sfa[2][4];
#pragma unroll
    for (int d = 0; d < 2; ++d) { const bf16_t* sp = ST + ((size_t)(cg_ * 4 + h) * 2 + d) * 16384 + (size_t)(16 * w + fr) * 128 + 8 * fq;
#pragma unroll
        for (int ks = 0; ks < 4; ++ks) sfa[d][ks] = *(const bf16x8*)(sp + 32 * ks); }
    if (nxt >= 0) tiles_load(tn, p, nxt, tid);
    f32x4 qv[4];
#pragma unroll
    for (int ib = 0; ib < 4; ++ib) { qv[ib][0] = bflo(qraw[ib][0]); qv[ib][1] = bfhi(qraw[ib][0]); qv[ib][2] = bflo(qraw[ib][1]); qv[ib][3] = bfhi(qraw[ib][1]); }
#pragma unroll
    for (int d = 0; d < 2; ++d) {
        const LAS unsigned char* Gt = d ? Gt1 : Gt0; LAS unsigned char* Qs = QK + d * 2 * 64 * TS; LAS unsigned char* Ks = Qs + 64 * TS;
        f32x4 bT[4]; cumsum_T(Gt, d, w, fr, fq, bT);
        const f32x4 bref = d ? bcast4(bT[2], 16 * fq) : bcast4(bT[1], 16 * fq + 15);
#pragma unroll
        for (int ib = 0; ib < 4; ++ib) {
            const int i = 16 * ib + fr; const int co = (16 * w + 4 * fq) * 2;
            const f32x4 gv = load4bf_lds(Gt + i * TS + co);
            f32x4 a, b;
#pragma unroll
            for (int e = 0; e < 4; ++e) {
                const float kk = 1.0f - __builtin_amdgcn_exp2f(gv[e]); const float db = bT[ib][e] - bref[e];
                a[e] = qv[ib][e] * __builtin_amdgcn_exp2f(db); b[e] = kk * __builtin_amdgcn_exp2f(-db);
            }
            *(LAS u32x2*)(Qs + i * TS + co) = pack4(a); *(LAS u32x2*)(Ks + i * TS + co) = pack4(b);
        }
    }
    __syncthreads();
#pragma unroll
    for (int d = 0; d < 2; ++d) {
        const LAS unsigned char* Qs = QK + d * 2 * 64 * TS; const LAS unsigned char* Ks = Qs + 64 * TS; LAS unsigned char* At = AtB + d * 64 * AS;
        const int ib = w >> 1;
        bf16x8 qf[4];
#pragma unroll
        for (int ks = 0; ks < 4; ++ks) qf[ks] = *(const LAS bf16x8*)(Qs + (16 * ib + fr) * TS + (32 * ks + 8 * fq) * 2);
#pragma unroll
        for (int jj = 0; jj < 2; ++jj) {
            const int jb = 2 * (w & 1) + jj;
            f32x4 a = (f32x4){0.f, 0.f, 0.f, 0.f};
#pragma unroll
            for (int ks = 0; ks < 4; ++ks) { const bf16x8 kf = *(const LAS bf16x8*)(Ks + (16 * jb + fr) * TS + (32 * ks + 8 * fq) * 2); a = mfma16(kf, qf[ks], a); }
            const int i = 16 * ib + fr;
#pragma unroll
            for (int e = 0; e < 4; ++e) { const int j = 16 * jb + 4 * fq + e; const bool on = d ? (j >= i) : (j <= i); a[e] = on ? a[e] : 0.f; }
            *(LAS u32x2*)(At + i * AS + (16 * jb + 4 * fq) * 2) = pack4(a);
        }
    }
    __syncthreads();
    f32x4 o[4];
#pragma unroll
    for (int ib = 0; ib < 4; ++ib) o[ib] = (f32x4){0.f, 0.f, 0.f, 0.f};
    {
        bf16x8 vf[2];
#pragma unroll
        for (int ks = 0; ks < 2; ++ks) vf[ks] = tr_frag(Vt, TS, 32 * ks + 8 * fq, 32 * ks + 8 * fq + 4, 16 * w, fr);
#pragma unroll
        for (int d = 0; d < 2; ++d) {
            const LAS unsigned char* Qs = QK + d * 2 * 64 * TS; const LAS unsigned char* At = AtB + d * 64 * AS;
#pragma unroll
            for (int ib = 0; ib < 4; ++ib) {
#pragma unroll
                for (int ks = 0; ks < 2; ++ks) { const bf16x8 af = *(const LAS bf16x8*)(At + (16 * ib + fr) * AS + (32 * ks + 8 * fq) * 2); o[ib] = mfma16(vf[ks], af, o[ib]); }
#pragma unroll
                for (int ks = 0; ks < 4; ++ks) { const bf16x8 qs = *(const LAS bf16x8*)(Qs + (16 * ib + fr) * TS + (32 * ks + 8 * fq) * 2); o[ib] = mfma16(sfa[d][ks], qs, o[ib]); }
            }
        }
    }
#pragma unroll
    for (int ib = 0; ib < 4; ++ib) {
        float s = o[ib][0] * o[ib][0] + o[ib][1] * o[ib][1] + o[ib][2] * o[ib][2] + o[ib][3] * o[ib][3];
        s += __shfl_xor(s, 16); s += __shfl_xor(s, 32);
        if (fq == 0) red[w * 64 + 16 * ib + fr] = s;
    }
    __syncthreads();
    const f32x4 gw = *(const f32x4*)(p.hgrn_norm_w + 128 * h + 16 * w + 4 * fq);
#pragma unroll
    for (int ib = 0; ib < 4; ++ib) {
        const int i = 16 * ib + fr; float tot = 0.f;
#pragma unroll
        for (int ww = 0; ww < 8; ++ww) tot += red[ww * 64 + i];
        const float rinv = rsqrtf(tot * (1.0f / 128.0f) + EPS);
        f32x4 hg; hg[0] = bflo(hgraw[ib][0]); hg[1] = bfhi(hgraw[ib][0]); hg[2] = bflo(hgraw[ib][1]); hg[3] = bfhi(hgraw[ib][1]);
        *(u32x2*)(obase + (size_t)(t0 + i) * old_ + 128 * h + 16 * w + 4 * fq) = pack4(o[ib] * rinv * gw * hg);
    }
    __syncthreads();
}

__device__ void hgrn_o_pass(LAS unsigned char* lds, const Params& p, int c, int G, bf16_t* obase, int old_) {
    const int tid = threadIdx.x; Tile3 t; int it = c;
    if (it < 3072) tiles_load(t, p, it, tid);
    for (; it < 3072; it += G) {
        tiles_store(lds, t, tid);
        __syncthreads();
        hgrn_o_compute(lds, p, it, obase, old_, t, (it + G < 3072) ? it + G : -1);
    }
}

#define XB_TMO      128
#define XB_XCNT(j)  (256  + 64 * (j))
#define XB_XSUB(j)  (1280 + 64 * (j))
#define XB_XGEN(j)  (2304 + 64 * (j))
#define XB_TOP      3328
#define XB_TOPGEN   3392
#define XCD_BAR_WORDS 3456
#define XB_SPIN_CAP (1u << 18)

__device__ __forceinline__ unsigned xb_ld(unsigned* p)              { return __hip_atomic_load(p, __ATOMIC_RELAXED, __HIP_MEMORY_SCOPE_AGENT); }
__device__ __forceinline__ unsigned xb_add(unsigned* p, unsigned v) { return __hip_atomic_fetch_add(p, v, __ATOMIC_RELAXED, __HIP_MEMORY_SCOPE_AGENT); }
__device__ __forceinline__ unsigned xb_xcc_id() { return (unsigned)__builtin_amdgcn_s_getreg((3 << 11) | 20) & 0xFu; }
#define XB_SPIN(cond, bar) do { unsigned _sp = 0; while (cond) { __builtin_amdgcn_s_sleep(1); \
    if ((++_sp & 255u) == 0u) { if (xb_ld(&(bar)[XB_TMO])) break; if (_sp > XB_SPIN_CAP) { atomicAdd(&(bar)[XB_TMO], 1u); break; } } } } while (0)

struct XcdBarrier {
    unsigned* bar; unsigned x;
    volatile LAS unsigned* st;
};

__device__ __forceinline__ XcdBarrier xcd_barrier_post(unsigned* bar, volatile LAS unsigned* st) {
    XcdBarrier b; b.bar = bar; b.x = xb_xcc_id(); b.st = st;
    if (threadIdx.x == 0) (void)xb_add(&bar[XB_XCNT(b.x)], 1u);
    return b;
}
__device__ __forceinline__ void xcd_barrier_complete(unsigned* bar, unsigned x, unsigned& nloc, unsigned& nx) {
    const unsigned G = gridDim.x * gridDim.y * gridDim.z;
    unsigned sum, cnt, mine, sp = 0u;
    for (;;) {
        sum = 0u; cnt = 0u; mine = 0u;
#pragma unroll
        for (unsigned j = 0; j < 16; ++j) { const unsigned c = xb_ld(&bar[XB_XCNT(j)]); sum += c; cnt += (c > 0u) ? 1u : 0u; mine = (j == x) ? c : mine; }
        if (sum == G) break;
        __builtin_amdgcn_s_sleep(1);
        if ((++sp & 255u) == 0u) { if (xb_ld(&bar[XB_TMO])) break; if (sp > XB_SPIN_CAP) { atomicAdd(&bar[XB_TMO], 1u); break; } }
    }
    nloc = mine > 0u ? mine : 1u; nx = cnt > 0u ? cnt : 1u;
}

__device__ __forceinline__ void xcd_barrier(const XcdBarrier& b) {
    asm volatile("s_waitcnt vmcnt(0)" ::: "memory");
    __syncthreads();
    if (threadIdx.x == 0) {
        unsigned* bar = b.bar;
        __builtin_amdgcn_s_waitcnt(0);
        unsigned nloc = b.st[0], nx = b.st[1];
        if (nloc == 0u) { xcd_barrier_complete(bar, b.x, nloc, nx); b.st[0] = nloc; b.st[1] = nx; }
        const unsigned old = xb_add(&bar[XB_XSUB(b.x)], 1u);
        const unsigned gen = old / nloc;
        if (old + 1u == (gen + 1u) * nloc) {
            __builtin_amdgcn_fence(__ATOMIC_RELEASE, "agent");
            asm volatile("s_waitcnt vmcnt(0)" ::: "memory");
            const unsigned og = xb_add(&bar[XB_TOP], 1u);
            const unsigned tg = og / nx;
            if (og + 1u == (tg + 1u) * nx) xb_add(&bar[XB_TOPGEN], 1u);
            else XB_SPIN(xb_ld(&bar[XB_TOPGEN]) == tg, bar);
            __builtin_amdgcn_fence(__ATOMIC_ACQUIRE, "agent");
            xb_add(&bar[XB_XGEN(b.x)], 1u);
            asm volatile("s_waitcnt vmcnt(0)" ::: "memory");
        } else {
            XB_SPIN(xb_ld(&bar[XB_XGEN(b.x)]) == gen, bar);
            __builtin_amdgcn_fence(__ATOMIC_ACQUIRE, "agent");
            asm volatile("s_waitcnt vmcnt(0)" ::: "memory");
        }
    }
    __syncthreads();
}


#ifdef ONLY_PH
#define PH_ON(k) ((k) == ONLY_PH && p.ph_lo <= (k) && (k) < p.ph_hi)
#else
#define PH_ON(k) (p.ph_lo <= (k) && (k) < p.ph_hi)
#endif
#ifndef DUP_PH
#define DUP_PH -1
#define DUP_N 0
#endif
#define NREP(k) ((DUP_PH == (k)) ? 1 + DUP_N : 1)
#define PH_SYNC(k) if (p.coop && p.ph_lo <= (k) && (k) + 1 < p.ph_hi) { xcd_barrier(xb); }
__global__ void __launch_bounds__(512, 2) fwd_kernel(Params p) {
    extern __shared__ __attribute__((aligned(16))) unsigned char shm_[];
    LAS unsigned char* lds = (LAS unsigned char*)shm_;
#ifdef XCD_CHUNKED
    const int G = gridDim.x, c = (blockIdx.x % (G / 8)) * 8 + blockIdx.x / (G / 8);
#else
    const int G = gridDim.x, c = blockIdx.x;
#endif
    unsigned char* ws = p.ws;
    volatile LAS unsigned* xst = (volatile LAS unsigned*)(lds + XST_OFF);
    if (threadIdx.x == 0) { xst[0] = 0u; xst[1] = 0u; }
    __syncthreads();
    XcdBarrier xb; xb.bar = (unsigned*)(ws + OFF_BAR); xb.x = 0; xb.st = xst;
    if (p.coop) xb = xcd_barrier_post((unsigned*)(ws + OFF_BAR), xst);
    if (p.pad0 == 0x7fffffff) cg::this_grid().sync();
    if (PH_ON(0)) for (int rep = 0; rep < NREP(0); ++rep) { phase_prep(p); if (rep + 1 < NREP(0)) xcd_barrier(xb); }
    PH_SYNC(0)
    if (PH_ON(1)) for (int rep = 0; rep < NREP(1); ++rep) { { pg8::Sched S; S.init(192, 13, G, c, 0); Epi1 E{p}; pg8::gemm_phase(lds, (const bf16_t*)(ws + OFF_H), (const bf16_t*)(ws + OFF_WIN), 1024, S, E); } if (rep + 1 < NREP(1)) xcd_barrier(xb); }
    PH_SYNC(1)
#ifndef DUP_A
#define DUP_A 0
#define DUP_U 0
#define DUP_O 0
#endif
    if (PH_ON(2)) { hgrn_u_pass(lds, p, c, G); }
    PH_SYNC(2)
#ifndef DUP_S
#define DUP_S 0
#endif
    if (PH_ON(3)) {
        for (int it = c; it < 320; it += G) hgrn_scan_item(p, it);
        volatile LAS unsigned* qw = (volatile LAS unsigned*)(lds + XST_OFF + 8);
        unsigned* qhead = (unsigned*)(ws + OFF_BAR + 16384);
        for (;;) {
            if (threadIdx.x == 0) *qw = __hip_atomic_fetch_add(qhead, 1u, __ATOMIC_RELAXED, __HIP_MEMORY_SCOPE_AGENT);
            __syncthreads();
            const unsigned item = *qw;
            if (item >= 768u) break;
            attn_item(lds, p, (int)item, (bf16_t*)(ws + OFF_QH), 1024);
        }
    }
    PH_SYNC(3)
    if (PH_ON(4)) {
        for (int rep = 0; rep <= DUP_O; ++rep) {
            bf16_t* ob = rep < DUP_O ? (bf16_t*)(ws + OFF_BAR + 65536) : (bf16_t*)(ws + OFF_QH) + 512; const int ol = rep < DUP_O ? 512 : 1024;
            hgrn_o_pass(lds, p, c, G, ob, ol);
            if (rep < DUP_O) xcd_barrier(xb);
        }
    }
    PH_SYNC(4)
    if (PH_ON(5)) for (int rep = 0; rep < NREP(5); ++rep) { { pg8::Sched S; S.init(192, 8, G, c, 0); EpiGate E{p}; pg8::gemm_phase(lds, (const bf16_t*)(ws + OFF_H), (const bf16_t*)(ws + OFF_WIN) + (size_t)3328 * 1024, 1024, S, E); } if (rep + 1 < NREP(5)) xcd_barrier(xb); }
    PH_SYNC(5)
#ifdef EXTRA_SYNCS
    for (int q = 0; q < EXTRA_SYNCS; ++q) xcd_barrier(xb);
#endif
    if (PH_ON(6)) {
        { unsigned char* XB = ws + OFF_H; const int gtid = c * 512 + threadIdx.x, gth = G * 512;
          for (int i = gtid; i < (128 + 4 * 192) * 128; i += gth) {
              const int rr = i >> 7, ch = i & 127; int row;
              if (rr < 128) row = rr == 0 ? 0 : 16384 + rr; else { const int q = rr - 128, sq = q / 192, k = q % 192; const int base = 16512 + 8384 * sq; row = k == 0 ? base : base + 8192 + k; }
              *(u32x4*)(XB + (unsigned)(row * 2048 + ch * 16)) = (u32x4){0u, 0u, 0u, 0u};
          } }
        pg8::Sched S; S.init(192, 4, G, c, 0); EpiMix E{p}; pg8::gemm_phase(lds, (const bf16_t*)(ws + OFF_QH), (const bf16_t*)(ws + OFF_WCAT), 1024, S, E); }
    PH_SYNC(6)
    if (PH_ON(7)) { pg8::Sched S; S.init(192, 4, G, c, 0); EpiX1 E{p}; pg8::gemm_phase(lds, (const bf16_t*)(ws + OFF_MIXED), (const bf16_t*)(ws + OFF_WMIX), 1024, S, E); }
    PH_SYNC(7)
    if (PH_ON(8)) for (int rep = 0; rep < NREP(8); ++rep) { { pg8::Sched S; S.init(197, 22, G, c, 1); EpiUp E{p, lds + 131072}; pg8::gemm_phase(lds, (const bf16_t*)(ws + OFF_H), (const bf16_t*)(ws + OFF_WUP), 1024, S, E); } if (rep + 1 < NREP(8)) xcd_barrier(xb); }
    PH_SYNC(8)
    if (PH_ON(9)) { pg8::Sched S; S.init(192, 4, G, c, 0); EpiDown E{p}; pg8::gemm_phase(lds, (const bf16_t*)(ws + OFF_ACT), (const bf16_t*)(ws + OFF_WDN), DFF, S, E); }
    PH_SYNC(9)
    if (PH_ON(10)) {
        const int wv = (c * 512 + threadIdx.x) >> 6, nwv = (G * 512) >> 6, lane = threadIdx.x & 63;
        const float* ss = (const float*)(ws + OFF_SS2); const unsigned char* XB = ws + OFF_H;
        f32x4 wf[2][2];
#pragma unroll
        for (int i = 0; i < 2; ++i) { wf[i][0] = *(const f32x4*)(p.norm_final_w + i * 512 + lane * 8); wf[i][1] = *(const f32x4*)(p.norm_final_w + i * 512 + lane * 8 + 4); }
        for (int r = wv; r < T_TOK; r += nwv) {
            const float rs = rsqrtf(ss[r] * (1.0f / 1024.0f) + EPS);
            const unsigned pr = (unsigned)(r + padoff_of(r));
#pragma unroll
            for (int i = 0; i < 2; ++i) {
                f32x4 a, b; load8((const bf16_t*)(XB + (unsigned)(pr * 2048 + (i * 512 + lane * 8) * 2)), a, b);
                float* o = p.out + (size_t)r * 1024 + i * 512 + lane * 8;
                __builtin_nontemporal_store(a * rs * wf[i][0], (f32x4*)o); __builtin_nontemporal_store(b * rs * wf[i][1], (f32x4*)(o + 4));
            }
        } }
}

#ifdef DBG_NANCHK
__global__ void dbg_init(unsigned* flag) { if (threadIdx.x == 0 && blockIdx.x == 0) { flag[0] = 99u; flag[1] = 0u; } }
__global__ void dbg_chk(const void* buf, size_t n, int is_f32, unsigned id, unsigned* flag) {
    bool bad = false;
    for (size_t i = (size_t)blockIdx.x * blockDim.x + threadIdx.x; i < n; i += (size_t)gridDim.x * blockDim.x) {
        float v = is_f32 ? ((const float*)buf)[i] : bf2f(((const bf16_t*)buf)[i]);
        if (!(fabsf(v) < 1e30f)) bad = true;
    }
    if (bad) atomicMin(flag, id);
}
__global__ void dbg_cnt(const void* buf, size_t n, unsigned* cnt) {
    unsigned c = 0;
    for (size_t i = (size_t)blockIdx.x * blockDim.x + threadIdx.x; i < n; i += (size_t)gridDim.x * blockDim.x) {
        float v = bf2f(((const bf16_t*)buf)[i]);
        if (!(fabsf(v) < 1e30f)) ++c;
    }
    if (c) atomicAdd(cnt, c);
}
__global__ void dbg_fin(float* out, const unsigned* flag) { if (threadIdx.x == 0 && blockIdx.x == 0) { unsigned f = flag[1]; out[0] = 100.0f * log2f(1.0f + (float)f); } }
#define CHK(ptr, n, f32, id) hipLaunchKernelGGL(dbg_chk, dim3(1024), dim3(256), 0, stream, (const void*)(ptr), (size_t)(n), f32, id, flag)
#endif
#ifdef DBG_UCHK
__global__ void dbg_ucheck(const unsigned char* ws, const float* outp, int cg_, int h, int dir, float* res) {
    const bf16_t* G = (const bf16_t*)(ws + (dir ? OFF_GB : OFF_GF)); const bf16_t* V = (const bf16_t*)(ws + OFF_HI);
    const bf16_t* ST = (const bf16_t*)outp;
    const int e = blockIdx.x * blockDim.x + threadIdx.x; if (e >= 16384) return;
    const int dv = e >> 7, dk = e & 127; const int t0 = cg_ * 64;
    float tot = 0.f; for (int t = 0; t < 64; ++t) tot += bf2f(G[(size_t)(t0 + t) * 512 + 128 * h + dk]);
    float u = 0.f, run = 0.f;
    for (int tt = 0; tt < 64; ++tt) { const int t = dir ? 63 - tt : tt; const float g = bf2f(G[(size_t)(t0 + t) * 512 + 128 * h + dk]); run += g;
        const float kd = (1.0f - expf(g)) * expf(tot - run); u += kd * bf2f(V[(size_t)(t0 + t) * 512 + 128 * h + dv]); }
    const float got = bf2f(ST[((size_t)(cg_ * 4 + h) * 2 + dir) * 16384 + dv * 128 + dk]);
    float d = fabsf(got - u); if (!(d < 1e30f)) d = 1e3f;
    atomicMax((unsigned*)res, __float_as_uint(d)); atomicMax((unsigned*)res + 1, __float_as_uint(fabsf(u)));
}
__global__ void dbg_stats(const unsigned char* ws, unsigned* fl) {
    const bf16_t* GF = (const bf16_t*)(ws + OFF_GF); const bf16_t* HI = (const bf16_t*)(ws + OFF_HI);
    unsigned f = 0;
    for (size_t i = (size_t)blockIdx.x * blockDim.x + threadIdx.x; i < (size_t)T_TOK * 1024; i += (size_t)gridDim.x * blockDim.x) {
        const float g = bf2f(GF[i]); if (g > 1e-3f) f |= 1u; if (g < -50.f) f |= 2u; }
    for (size_t i = (size_t)blockIdx.x * blockDim.x + threadIdx.x; i < (size_t)T_TOK * 512; i += (size_t)gridDim.x * blockDim.x) {
        const float v = bf2f(HI[i]); if (fabsf(v) > 100.f) f |= 4u; }
    if (f) atomicOr(fl, f);
}
__global__ void dbg_ufin(float* out, const float* res) { if (threadIdx.x == 0 && blockIdx.x == 0) { unsigned f = ((const unsigned*)res)[2]; if (!(res[1] < 1e30f)) f |= 8u; out[0] = 100.0f * (float)(1u + f); } }
#endif
extern "C" void kernel_launch(void* const* d_in, const int* in_sizes, int n_in, void* d_out, int out_size, void* d_ws, size_t ws_size, hipStream_t stream) {
    static int grid_blocks = 0;
    if (!grid_blocks) {
        hipFuncSetAttribute((const void*)fwd_kernel, hipFuncAttributeMaxDynamicSharedMemorySize, LDS_BYTES);
        int dev = 0, cus = 0, per_cu = 0;
        hipGetDevice(&dev);
        hipDeviceGetAttribute(&cus, hipDeviceAttributeMultiprocessorCount, dev);
        hipOccupancyMaxActiveBlocksPerMultiprocessor(&per_cu, fwd_kernel, 512, LDS_BYTES);
        if (per_cu < 1) per_cu = 1;
        grid_blocks = cus * 1;
    }
    Params p{};
    p.x_prompt = (const float*)d_in[0]; p.x_sample = (const float*)d_in[1]; p.norm_mix_w = (const float*)d_in[2]; p.w_in = (const float*)d_in[3];
    p.attn_sink = (const float*)d_in[4]; p.lb_logits = (const float*)d_in[5]; p.hgrn_norm_w = (const float*)d_in[6]; p.w_attn_out = (const float*)d_in[7];
    p.w_hgrn_out = (const float*)d_in[8]; p.w_mix_out = (const float*)d_in[9]; p.norm_ffn_w = (const float*)d_in[10]; p.w_up = (const float*)d_in[11];
    p.conv_w = (const float*)d_in[12]; p.conv_b = (const float*)d_in[13]; p.w_down = (const float*)d_in[14]; p.norm_final_w = (const float*)d_in[15];
    p.out = (float*)d_out; p.ws = (unsigned char*)d_ws; p.pad0 = 0;
    if (ws_size < WS_END + ((size_t)64 << 20)) { fprintf(stderr, "workspace too small: %zu < %zu\n", ws_size, (size_t)WS_END); return; }
#if MEGA
    p.ph_lo = 0; p.ph_hi = 11; p.coop = 1;
    (void)hipMemsetAsync((unsigned char*)d_ws + OFF_BAR, 0, 16384 + 1024, stream);
    void* args[] = {&p};
    hipError_t e = hipLaunchCooperativeKernel((const void*)fwd_kernel, dim3(grid_blocks), dim3(512), args, LDS_BYTES, stream);
    if (e != hipSuccess) fprintf(stderr, "cooperative launch failed: %s (grid %d)\n", hipGetErrorString(e), grid_blocks);
#else
#ifdef DBG_NANCHK
    unsigned* flag = (unsigned*)((unsigned char*)d_ws + WS_END + 256);
    unsigned char* w = (unsigned char*)d_ws;
    hipLaunchKernelGGL(dbg_init, dim3(1), dim3(64), 0, stream, flag);
#endif
    for (int ph = 0; ph < 11; ++ph) {
        p.ph_lo = ph; p.ph_hi = ph + 1; p.coop = 0;
#ifdef DBG_NANCHK
        if (ph == 2) hipMemsetAsync(d_out, 0, (size_t)T_TOK * 4096, stream);
#endif
        hipLaunchKernelGGL(fwd_kernel, dim3(grid_blocks), dim3(512), LDS_BYTES, stream, p);
#ifdef DBG_UCHK
        if (ph == 2) { float* res = (float*)((unsigned char*)d_ws + WS_END + 512); hipMemsetAsync(res, 0, 16, stream); hipLaunchKernelGGL(dbg_stats, dim3(1024), dim3(256), 0, stream, (const unsigned char*)d_ws, (unsigned*)res + 2);
            for (int dd = 0; dd < 2; ++dd) { hipLaunchKernelGGL(dbg_ucheck, dim3(64), dim3(256), 0, stream, (const unsigned char*)d_ws, (const float*)d_out, 5, 1, dd, res);
                                             hipLaunchKernelGGL(dbg_ucheck, dim3(64), dim3(256), 0, stream, (const unsigned char*)d_ws, (const float*)d_out, 700, 3, dd, res); } }
#endif
#ifdef DBG_NANCHK
        const size_t T = T_TOK;
        if (ph == 0) { CHK(w + OFF_WIN, (size_t)DIN * 1024, 0, 1u); CHK(w + OFF_WCAT, 1024 * 1024, 0, 2u); CHK(w + OFF_WMIX, 1024 * 1024, 0, 3u); CHK(w + OFF_WUP, 5632 * 1024, 0, 4u);
                       CHK(w + OFF_WDN, 1024 * DFF, 0, 5u); CHK(w + OFF_ROTC, 2 * 16384 * 32, 1, 6u); CHK(w + OFF_H, T * 1024, 0, 7u); }
        if (ph == 1) { CHK(w + OFF_QH, T * 1024, 0, 8u); CHK(w + OFF_K, T * 128, 0, 9u); CHK(w + OFF_V, T * 128, 0, 10u); CHK(w + OFF_GF, T * 512, 0, 11u); CHK(w + OFF_GB, T * 512, 0, 12u);
                       CHK(w + OFF_HI, T * 512, 0, 13u); CHK(w + OFF_HG, T * 512, 0, 14u); }
        if (ph == 2) { hipLaunchKernelGGL(dbg_cnt, dim3(1024), dim3(256), 0, stream, (const void*)d_out, (size_t)T * 2048, flag + 1); CHK(w + OFF_QH, T * 1024, 0, 15u); CHK(d_out, T * 2048, 0, 16u); CHK(w + OFF_DC, (size_t)NCHUNK * 8 * 128, 1, 17u); }
        if (ph == 3) { CHK(d_out, T * 2048, 0, 18u); }
        if (ph == 4) { CHK(w + OFF_QH, T * 1024, 0, 19u); }
        if (ph == 5) { CHK(d_out, T * 2048, 0, 20u); }
        if (ph == 6) { CHK(w + OFF_MIXED, T * 1024, 0, 21u); }
        if (ph == 7) { CHK(d_out, T * 1024, 1, 22u); CHK(w + OFF_SS1, T, 1, 23u); CHK(w + OFF_H, (size_t)PADROWS * 1024, 0, 24u); }
        if (ph == 8) { CHK(w + OFF_ACT, T * DFF, 0, 25u); }
        if (ph == 9) { CHK(d_out, T * 1024, 1, 26u); CHK(w + OFF_SS2, T, 1, 27u); }
#endif
    }
#ifdef DBG_UCHK
    hipLaunchKernelGGL(dbg_ufin, dim3(1), dim3(64), 0, stream, (float*)d_out, (const float*)((unsigned char*)d_ws + WS_END + 512));
#endif
#ifdef DBG_NANCHK
    hipLaunchKernelGGL(dbg_fin, dim3(1), dim3(64), 0, stream, (float*)d_out, flag);
#endif
#endif
}
```
